# Optimizing an MI355X kernel written in HIP

```python
import math
import jax
import jax.numpy as jnp
from jax import lax
import numpy as np

D_MODEL = 1024
BATCH = 16
SEQ = 2048
DEPTH = 2

GRID_W = 64
CTX_LEN = 256
HEAD_DIM = 64
Q_BLOCK = 128
D_FF = 2816
N_MOD = 9
ROPE_BASE = 10000.0
EPS = 1e-6
NEG = -1e30
A_HEADS = 8
A_KV_HEADS = 2
A_WINDOW = 128
B_HEADS = 4
B_V_DIM = 2 * HEAD_DIM
C_HEADS = 8
C_Q_RANK = 768
C_KV_RANK = 256
C_NOPE = 64
C_ROPE = 32
C_V = 64
D_HEADS = 8
D_WIN_ROWS = 8
D_WIN_COLS = 16
N_EVEN = (DEPTH + 1) // 2
N_ODD = DEPTH // 2
AB_SPLITS = (A_HEADS * HEAD_DIM, B_HEADS * 2 * HEAD_DIM, A_KV_HEADS * HEAD_DIM, A_KV_HEADS * HEAD_DIM, B_HEADS * 2 * HEAD_DIM, B_HEADS * B_V_DIM)
AB_Q_WIDTH = AB_SPLITS[0] + AB_SPLITS[1]
AB_IN = sum(AB_SPLITS)
AB_OUT = A_HEADS * HEAD_DIM + B_HEADS * B_V_DIM
CD_SPLITS = (C_Q_RANK, D_HEADS * HEAD_DIM, C_KV_RANK + C_ROPE, D_HEADS * HEAD_DIM, D_HEADS * HEAD_DIM)
CD_Q_WIDTH = CD_SPLITS[0] + CD_SPLITS[1]
CD_IN = sum(CD_SPLITS)
CD_OUT = C_HEADS * C_V + D_HEADS * HEAD_DIM

kernel_name = "hybrid_dit_window_diff_mla_natten_macaron"


def split_cols(t, sizes):
    cuts = [int(v) for v in np.cumsum(sizes)[:-1]]
    return jnp.split(t, cuts, axis=-1)


def rms_norm(x, gain=None):
    xf = x.astype(jnp.float32)
    y = xf * lax.rsqrt(jnp.mean(xf * xf, axis=-1, keepdims=True) + EPS)
    if gain is not None:
        y = y * gain.astype(jnp.float32)
    return y.astype(x.dtype)


def modulate(h, shift, scale):
    return h * (1.0 + scale) + shift


def swiglu(h, w_gate, w_up, w_down):
    return (jax.nn.silu(h @ w_gate) * (h @ w_up)) @ w_down


def axial_rope_tables(n, rot_dim):
    nf = rot_dim // 4
    inv = ROPE_BASE ** (-jnp.arange(nf, dtype=jnp.float32) / nf)
    t = jnp.arange(n)
    row = (t // GRID_W).astype(jnp.float32)
    col = (t % GRID_W).astype(jnp.float32)
    ang = jnp.concatenate([row[:, None] * inv, col[:, None] * inv], axis=-1)
    return jnp.cos(ang), jnp.sin(ang)


def apply_rope2d(x, cos, sin):
    nf = x.shape[-1] // 4
    xf = x.astype(jnp.float32).reshape(x.shape[:-1] + (2, 2, nf))
    x1, x2 = xf[..., 0, :], xf[..., 1, :]
    c = cos.reshape(cos.shape[0], 1, 2, nf)
    s = sin.reshape(sin.shape[0], 1, 2, nf)
    out = jnp.stack([x1 * c - x2 * s, x2 * c + x1 * s], axis=-2)
    return out.reshape(x.shape).astype(x.dtype)


def joint_softmax(scores, sink=None):
    m = scores[0].max(axis=-1, keepdims=True)
    for s in scores[1:]:
        m = jnp.maximum(m, s.max(axis=-1, keepdims=True))
    if sink is not None:
        m = jnp.maximum(m, sink)
    es = [jnp.exp(s - m) for s in scores]
    denom = es[0].sum(axis=-1, keepdims=True)
    for e in es[1:]:
        denom = denom + e.sum(axis=-1, keepdims=True)
    if sink is not None:
        denom = denom + jnp.exp(sink - m)
    return [e / denom for e in es]


def sweep_blocks(fn, q, block):
    B, S = q.shape[0], q.shape[1]
    nb = S // block
    qb = jnp.moveaxis(q.reshape((B, nb, block) + q.shape[2:]), 1, 0)
    out = lax.map(lambda a: fn(a[0], a[1]), (qb, jnp.arange(nb)))
    return jnp.moveaxis(out, 0, 1).reshape((B, S) + out.shape[3:])


def gqa_attend(q, keyvals, sink=None):
    B, Q, H, d = q.shape
    kvh = keyvals[0][0].shape[2]
    g = H // kvh
    qg = q.reshape(B, Q, kvh, g, d)
    scores = []
    for k, _, mask in keyvals:
        s = jnp.einsum('bqhgd,bkhd->bhgqk', qg, k).astype(jnp.float32) * (d ** -0.5)
        if mask is not None:
            s = jnp.where(mask, s, NEG)
        scores.append(s)
    sink_b = None if sink is None else sink.astype(jnp.float32).reshape(kvh, g, 1, 1)
    probs = joint_softmax(scores, sink_b)
    out = None
    for p, (_, v, _) in zip(probs, keyvals):
        o = jnp.einsum('bhgqk,bkhd->bqhgd', p.astype(v.dtype), v)
        out = o if out is None else out + o
    return out.reshape(B, Q, H, d)


def windowed_sink_attention(q, k, v, k_ctx, v_ctx, sink):
    S = q.shape[1]
    span = Q_BLOCK + 2 * A_WINDOW
    pad = ((0, 0), (A_WINDOW, A_WINDOW), (0, 0), (0, 0))
    k_pad = jnp.pad(k, pad)
    v_pad = jnp.pad(v, pad)

    def block(q_blk, n):
        start = n * Q_BLOCK
        k_blk = lax.dynamic_slice_in_dim(k_pad, start, span, axis=1)
        v_blk = lax.dynamic_slice_in_dim(v_pad, start, span, axis=1)
        q_pos = start + jnp.arange(Q_BLOCK)
        k_pos = start - A_WINDOW + jnp.arange(span)
        mask = ((jnp.abs(q_pos[:, None] - k_pos[None, :]) <= A_WINDOW)
                & (k_pos >= 0)[None, :] & (k_pos < S)[None, :])
        return gqa_attend(q_blk, [(k_blk, v_blk, mask), (k_ctx, v_ctx, None)], sink)

    return sweep_blocks(block, q, Q_BLOCK)


def diff_lambda(lq1, lk1, lq2, lk2, lam_init):
    f = jnp.float32
    return (jnp.exp(jnp.sum(lq1.astype(f) * lk1.astype(f)))
            - jnp.exp(jnp.sum(lq2.astype(f) * lk2.astype(f))) + lam_init)


def diff_qk(t, gain, rope):
    B, n, _ = t.shape
    t = rms_norm(t.reshape(B, n, 2 * B_HEADS, HEAD_DIM), gain)
    if rope is not None:
        t = apply_rope2d(t, *rope)
    return t.reshape(B, n, B_HEADS, 2, HEAD_DIM)


def diff_attend(q, k, v, lam):
    s = jnp.einsum('bqhmd,bkhmd->bhmqk', q, k).astype(jnp.float32) * (HEAD_DIM ** -0.5)
    p = jax.nn.softmax(s, axis=-1)
    w = p[:, :, 0] - lam * p[:, :, 1]
    return jnp.einsum('bhqk,bkhe->bqhe', w.astype(v.dtype), v)


def mla_queries(dq, q_a_norm, w_uq, qn_nope, qn_rope, rope):
    B, n, _ = dq.shape
    q = (rms_norm(dq, q_a_norm) @ w_uq).reshape(B, n, C_HEADS, C_NOPE + C_ROPE)
    q_nope = rms_norm(q[..., :C_NOPE], qn_nope)
    q_rope = rms_norm(q[..., C_NOPE:], qn_rope)
    if rope is not None:
        q_rope = apply_rope2d(q_rope, *rope)
    return jnp.concatenate([q_nope, q_rope], axis=-1)


def mla_keys_values(dkv, kv_a_norm, w_ukv, kn_nope, kn_rope, rope):
    B, n, _ = dkv.shape
    c_kv, k_rope = dkv[..., :C_KV_RANK], dkv[..., C_KV_RANK:]
    kv = (rms_norm(c_kv, kv_a_norm) @ w_ukv).reshape(B, n, C_HEADS, C_NOPE + C_V)
    k_nope = rms_norm(kv[..., :C_NOPE], kn_nope)
    k_rope = rms_norm(k_rope, kn_rope)[:, :, None, :]
    if rope is not None:
        k_rope = apply_rope2d(k_rope, *rope)
    return k_nope, k_rope[:, :, 0, :], kv[..., C_NOPE:]


def mla_attend(q, k_nope, k_rope, v):
    q_nope, q_rope = q[..., :C_NOPE], q[..., C_NOPE:]
    s = (jnp.einsum('bqhd,bkhd->bhqk', q_nope, k_nope)
         + jnp.einsum('bqhr,bkr->bhqk', q_rope, k_rope)).astype(jnp.float32) * ((C_NOPE + C_ROPE) ** -0.5)
    p = jax.nn.softmax(s, axis=-1)
    return jnp.einsum('bhqk,bkhd->bqhd', p.astype(v.dtype), v)


def neighbourhood_attention(q, k, v, k_ctx, v_ctx, rpb):
    B, S, H, d = q.shape
    rows = S // GRID_W
    kh = min(D_WIN_ROWS, rows)
    kw = D_WIN_COLS
    k_grid = k.reshape(B, rows, GRID_W, H, d)
    v_grid = v.reshape(B, rows, GRID_W, H, d)
    cols = jnp.arange(GRID_W)
    col_start = jnp.clip(cols - kw // 2, 0, GRID_W - kw)
    col_mask = (cols[None, :] >= col_start[:, None]) & (cols[None, :] < col_start[:, None] + kw)
    dc_idx = jnp.clip(cols[None, :] - cols[:, None], -(kw - 1), kw - 1) + (D_WIN_COLS - 1)
    scale = d ** -0.5
    rpb_f = rpb.astype(jnp.float32)

    def row_block(q_row, r):
        row_start = jnp.clip(r - kh // 2, 0, rows - kh)
        k_band = lax.dynamic_slice_in_dim(k_grid, row_start, kh, axis=1)
        v_band = lax.dynamic_slice_in_dim(v_grid, row_start, kh, axis=1)
        dr_idx = row_start + jnp.arange(kh) - r + (D_WIN_ROWS - 1)
        bias = rpb_f[:, dr_idx[None, :, None], dc_idx[:, None, :]]
        s = jnp.einsum('bqhd,bjkhd->bhqjk', q_row, k_band).astype(jnp.float32) * scale + bias
        s = jnp.where(col_mask[:, None, :], s, NEG).reshape(B, H, GRID_W, kh * GRID_W)
        s_ctx = jnp.einsum('bqhd,bchd->bhqc', q_row, k_ctx).astype(jnp.float32) * scale
        p, p_ctx = joint_softmax([s, s_ctx])
        p = p.reshape(B, H, GRID_W, kh, GRID_W).astype(v.dtype)
        return (jnp.einsum('bhqjk,bjkhd->bqhd', p, v_band)
                + jnp.einsum('bhqc,bchd->bqhd', p_ctx.astype(v.dtype), v_ctx))

    return sweep_blocks(row_block, q, GRID_W)


def mix_window_diff(h, hc, w_in, w_out, a_q_norm, a_k_norm, a_sink, b_q_norm, b_k_norm,
                    b_lq1, b_lk1, b_lq2, b_lk2, b_sub_norm, lam_init, rope, need_ctx):
    B, S, _ = h.shape
    L = hc.shape[1]
    aq, bq, ak, av, bk, bv = split_cols(h @ w_in, AB_SPLITS)
    ak_c, av_c, bk_c, bv_c = split_cols(hc @ w_in[:, AB_Q_WIDTH:], AB_SPLITS[2:])
    aq = apply_rope2d(rms_norm(aq.reshape(B, S, A_HEADS, HEAD_DIM), a_q_norm), *rope)
    ak = apply_rope2d(rms_norm(ak.reshape(B, S, A_KV_HEADS, HEAD_DIM), a_k_norm), *rope)
    av = av.reshape(B, S, A_KV_HEADS, HEAD_DIM)
    ak_c = rms_norm(ak_c.reshape(B, L, A_KV_HEADS, HEAD_DIM), a_k_norm)
    av_c = av_c.reshape(B, L, A_KV_HEADS, HEAD_DIM)
    y_a = windowed_sink_attention(aq, ak, av, ak_c, av_c, a_sink)
    lam = diff_lambda(b_lq1, b_lk1, b_lq2, b_lk2, lam_init)
    bq = diff_qk(bq, b_q_norm, rope)
    bk = diff_qk(bk, b_k_norm, rope)
    bv = bv.reshape(B, S, B_HEADS, B_V_DIM)
    bk_c = diff_qk(bk_c, b_k_norm, None)
    bv_c = bv_c.reshape(B, L, B_HEADS, B_V_DIM)
    k_all = jnp.concatenate([bk_c, bk], axis=1)
    v_all = jnp.concatenate([bv_c, bv], axis=1)
    y_b = sweep_blocks(lambda q_blk, n: diff_attend(q_blk, k_all, v_all, lam), bq, Q_BLOCK)
    y_b = rms_norm(y_b, b_sub_norm) * (1.0 - lam_init)
    y = jnp.concatenate([y_a.reshape(B, S, -1), y_b.reshape(B, S, -1)], axis=-1) @ w_out
    if not need_ctx:
        return y, None
    aq_c, bq_c = split_cols(hc @ w_in[:, :AB_Q_WIDTH], AB_SPLITS[:2])
    aq_c = rms_norm(aq_c.reshape(B, L, A_HEADS, HEAD_DIM), a_q_norm)
    y_a_c = gqa_attend(aq_c, [(ak_c, av_c, None)], a_sink)
    y_b_c = rms_norm(diff_attend(diff_qk(bq_c, b_q_norm, None), bk_c, bv_c, lam), b_sub_norm) * (1.0 - lam_init)
    y_c = jnp.concatenate([y_a_c.reshape(B, L, -1), y_b_c.reshape(B, L, -1)], axis=-1) @ w_out
    return y, y_c


def mix_mla_neighbourhood(h, hc, w_in, w_out, c_q_a_norm, c_kv_a_norm, c_w_uq, c_w_ukv,
                          c_q_nope_norm, c_q_rope_norm, c_k_nope_norm, c_k_rope_norm,
                          d_q_norm, d_k_norm, d_rpb, rope, need_ctx):
    B, S, _ = h.shape
    L = hc.shape[1]
    cq, dq, ckv, dk, dv = split_cols(h @ w_in, CD_SPLITS)
    ckv_c, dk_c, dv_c = split_cols(hc @ w_in[:, CD_Q_WIDTH:], CD_SPLITS[2:])
    q = mla_queries(cq, c_q_a_norm, c_w_uq, c_q_nope_norm, c_q_rope_norm, rope)
    kn, kr, v = mla_keys_values(ckv, c_kv_a_norm, c_w_ukv, c_k_nope_norm, c_k_rope_norm, rope)
    kn_c, kr_c, v_c = mla_keys_values(ckv_c, c_kv_a_norm, c_w_ukv, c_k_nope_norm, c_k_rope_norm, None)
    kn_all = jnp.concatenate([kn_c, kn], axis=1)
    kr_all = jnp.concatenate([kr_c, kr], axis=1)
    v_all = jnp.concatenate([v_c, v], axis=1)
    y_mla = sweep_blocks(lambda q_blk, n: mla_attend(q_blk, kn_all, kr_all, v_all), q, Q_BLOCK)
    dq = rms_norm(dq.reshape(B, S, D_HEADS, HEAD_DIM), d_q_norm)
    dk = rms_norm(dk.reshape(B, S, D_HEADS, HEAD_DIM), d_k_norm)
    dv = dv.reshape(B, S, D_HEADS, HEAD_DIM)
    dk_c = rms_norm(dk_c.reshape(B, L, D_HEADS, HEAD_DIM), d_k_norm)
    dv_c = dv_c.reshape(B, L, D_HEADS, HEAD_DIM)
    y_nat = neighbourhood_attention(dq, dk, dv, dk_c, dv_c, d_rpb)
    y = jnp.concatenate([y_mla.reshape(B, S, -1), y_nat.reshape(B, S, -1)], axis=-1) @ w_out
    if not need_ctx:
        return y, None
    cq_c, dq_c = split_cols(hc @ w_in[:, :CD_Q_WIDTH], CD_SPLITS[:2])
    y_mla_c = mla_attend(mla_queries(cq_c, c_q_a_norm, c_w_uq, c_q_nope_norm, c_q_rope_norm, None), kn_c, kr_c, v_c)
    y_nat_c = gqa_attend(rms_norm(dq_c.reshape(B, L, D_HEADS, HEAD_DIM), d_q_norm), [(dk_c, dv_c, None)])
    y_c = jnp.concatenate([y_mla_c.reshape(B, L, -1), y_nat_c.reshape(B, L, -1)], axis=-1) @ w_out
    return y, y_c


def setup_inputs(seed: int = 0) -> dict:
    key = jax.random.key(seed)
    ks = jax.random.split(key, 37)
    f32 = jnp.float32

    def nrm(i, shape, scale):
        return scale * jax.random.normal(ks[i], shape, f32)

    def gain(i, shape):
        return 1.0 + 0.05 * jax.random.normal(ks[i], shape, f32)

    D, F, NE, NO = D_MODEL, D_FF, N_EVEN, N_ODD
    return {
        "x": nrm(0, (BATCH, SEQ, D), 1.0),
        "c": nrm(1, (BATCH, D), 1.0),
        "ctx": nrm(2, (BATCH, CTX_LEN, D), 1.0),
        "c_ctx": nrm(3, (D,), 1.0),
        "w_mod": nrm(4, (DEPTH, D, N_MOD * D), 0.5 * D ** -0.5),
        "b_mod": nrm(5, (DEPTH, N_MOD * D), 0.02),
        "ffn1_w_gate": nrm(6, (DEPTH, D, F), D ** -0.5),
        "ffn1_w_up": nrm(7, (DEPTH, D, F), D ** -0.5),
        "ffn1_w_down": nrm(8, (DEPTH, F, D), F ** -0.5),
        "ffn2_w_gate": nrm(9, (DEPTH, D, F), D ** -0.5),
        "ffn2_w_up": nrm(10, (DEPTH, D, F), D ** -0.5),
        "ffn2_w_down": nrm(11, (DEPTH, F, D), F ** -0.5),
        "ab_w_in": nrm(12, (NE, D, AB_IN), D ** -0.5),
        "ab_w_out": nrm(13, (NE, AB_OUT, D), AB_OUT ** -0.5),
        "a_q_norm": gain(14, (NE, HEAD_DIM)),
        "a_k_norm": gain(15, (NE, HEAD_DIM)),
        "a_sink": nrm(16, (NE, A_HEADS), 0.5),
        "b_q_norm": gain(17, (NE, HEAD_DIM)),
        "b_k_norm": gain(18, (NE, HEAD_DIM)),
        "b_lambda_q1": nrm(19, (NE, HEAD_DIM), 0.1),
        "b_lambda_k1": nrm(20, (NE, HEAD_DIM), 0.1),
        "b_lambda_q2": nrm(21, (NE, HEAD_DIM), 0.1),
        "b_lambda_k2": nrm(22, (NE, HEAD_DIM), 0.1),
        "b_sub_norm": gain(23, (NE, B_V_DIM)),
        "cd_w_in": nrm(24, (NO, D, CD_IN), D ** -0.5),
        "cd_w_out": nrm(25, (NO, CD_OUT, D), CD_OUT ** -0.5),
        "c_q_a_norm": gain(26, (NO, C_Q_RANK)),
        "c_kv_a_norm": gain(27, (NO, C_KV_RANK)),
        "c_w_uq": nrm(28, (NO, C_Q_RANK, C_HEADS * (C_NOPE + C_ROPE)), C_Q_RANK ** -0.5),
        "c_w_ukv": nrm(29, (NO, C_KV_RANK, C_HEADS * (C_NOPE + C_V)), C_KV_RANK ** -0.5),
        "c_q_nope_norm": gain(30, (NO, C_NOPE)),
        "c_q_rope_norm": gain(31, (NO, C_ROPE)),
        "c_k_nope_norm": gain(32, (NO, C_NOPE)),
        "c_k_rope_norm": gain(33, (NO, C_ROPE)),
        "d_q_norm": gain(34, (NO, HEAD_DIM)),
        "d_k_norm": gain(35, (NO, HEAD_DIM)),
        "d_rpb": nrm(36, (NO, D_HEADS, 2 * D_WIN_ROWS - 1, 2 * D_WIN_COLS - 1), 0.5),
    }


def reference(x, c, ctx, c_ctx, w_mod, b_mod,
              ffn1_w_gate, ffn1_w_up, ffn1_w_down, ffn2_w_gate, ffn2_w_up, ffn2_w_down,
              ab_w_in, ab_w_out, a_q_norm, a_k_norm, a_sink, b_q_norm, b_k_norm,
              b_lambda_q1, b_lambda_k1, b_lambda_q2, b_lambda_k2, b_sub_norm,
              cd_w_in, cd_w_out, c_q_a_norm, c_kv_a_norm, c_w_uq, c_w_ukv,
              c_q_nope_norm, c_q_rope_norm, c_k_nope_norm, c_k_rope_norm,
              d_q_norm, d_k_norm, d_rpb):
    S = x.shape[1]
    rope_head = axial_rope_tables(S, HEAD_DIM)
    rope_mla = axial_rope_tables(S, C_ROPE)
    c_act = jax.nn.silu(c)
    c_ctx_act = jax.nn.silu(c_ctx)
    xc = ctx
    for l in range(DEPTH):
        need_ctx = l < DEPTH - 1
        mx = jnp.split((c_act @ w_mod[l] + b_mod[l])[:, None, :], N_MOD, axis=-1)
        mc = jnp.split((c_ctx_act @ w_mod[l] + b_mod[l])[None, None, :], N_MOD, axis=-1)
        ffn1 = (ffn1_w_gate[l], ffn1_w_up[l], ffn1_w_down[l])
        ffn2 = (ffn2_w_gate[l], ffn2_w_up[l], ffn2_w_down[l])
        x = x + 0.5 * mx[2] * swiglu(modulate(rms_norm(x), mx[0], mx[1]), *ffn1)
        xc = xc + 0.5 * mc[2] * swiglu(modulate(rms_norm(xc), mc[0], mc[1]), *ffn1)
        h = modulate(rms_norm(x), mx[3], mx[4])
        hc = modulate(rms_norm(xc), mc[3], mc[4])
        i = l // 2
        if l % 2 == 0:
            lam_init = 0.8 - 0.6 * math.exp(-0.3 * l)
            y, y_c = mix_window_diff(h, hc, ab_w_in[i], ab_w_out[i], a_q_norm[i], a_k_norm[i], a_sink[i],
                                     b_q_norm[i], b_k_norm[i], b_lambda_q1[i], b_lambda_k1[i],
                                     b_lambda_q2[i], b_lambda_k2[i], b_sub_norm[i], lam_init,
                                     rope_head, need_ctx)
        else:
            y, y_c = mix_mla_neighbourhood(h, hc, cd_w_in[i], cd_w_out[i], c_q_a_norm[i], c_kv_a_norm[i],
                                           c_w_uq[i], c_w_ukv[i], c_q_nope_norm[i], c_q_rope_norm[i],
                                           c_k_nope_norm[i], c_k_rope_norm[i], d_q_norm[i], d_k_norm[i],
                                           d_rpb[i], rope_mla, need_ctx)
        x = x + mx[5] * y
        x = x + 0.5 * mx[8] * swiglu(modulate(rms_norm(x), mx[6], mx[7]), *ffn2)
        if need_ctx:
            xc = xc + mc[5] * y_c
            xc = xc + 0.5 * mc[8] * swiglu(modulate(rms_norm(xc), mc[6], mc[7]), *ffn2)
    return x
```

```cpp
#include <hip/hip_runtime.h>
#include <hip/hip_cooperative_groups.h>
#include <cstdio>
#include <cstdint>
namespace cg = cooperative_groups;
namespace pg8 {
#define PG8_LAS __attribute__((address_space(3)))
typedef unsigned short bf16_t;
typedef short bf16x8 __attribute__((ext_vector_type(8)));
typedef float f32x4 __attribute__((ext_vector_type(4)));
typedef unsigned u32x4 __attribute__((ext_vector_type(4)));
constexpr int BM = 256, BK = 64, HALF = 128, HTB = HALF * BK * 2  , STAGE_BYTES = 8 * HTB, NXCD = 8, WGM = 8;

__host__ __device__ __forceinline__ int lds_byte(int r, int c) { const int st = (r >> 4) * 2 + (c >> 5), rr = r & 15, cc = c & 31, ob = rr * 64 + cc * 2; return st * 1024 + (ob ^ (((ob >> 9) & 1) << 5)); }
__host__ __device__ __forceinline__ void stage_rc(int b, int& R, int& C) { const int st = b / 1024, sb = b % 1024, swz = sb ^ (((sb >> 9) & 1) << 5); R = (st >> 1) * 16 + swz / 64; C = (st & 1) * 32 + (swz % 64) / 2; }
__host__ __device__ __forceinline__ int perm32(int rho) { const int n = rho >> 4, i = rho & 15; return 8 * (i >> 2) + 4 * n + (i & 3); }

struct Unit { int pm, pn; };
struct Gemm { const bf16_t* A; const bf16_t* Bt; int M, N, K, ld; };

struct StaticOrder {
    int nM, nN, nwg, G, c;
    __host__ __device__ void init(int M, int N, int G_, int c_) { nM = M / BM; nN = N / BM; nwg = nM * nN; G = G_; c = c_; }
    __host__ __device__ bool next(int i, Unit& u) const {
        const long L = (long)i * G + c; if (L >= nwg) return false;
        int wgid = (int)L; { const int q = nwg / NXCD, r = nwg % NXCD, xcd = wgid % NXCD, off = wgid / NXCD; wgid = (xcd < r ? xcd * (q + 1) : r * (q + 1) + (xcd - r) * q) + off; }
        const int nig = WGM * nN, gid = wgid / nig, fm = gid * WGM, gsz = (nM - fm) < WGM ? (nM - fm) : WGM;
        u.pm = fm + ((wgid % nig) % gsz); u.pn = (wgid % nig) / gsz; return true;
    }
    __device__ __forceinline__ void a_ready(const Unit&) const {}
    __device__ __forceinline__ void done(const Unit&) const {}
};

__device__ __forceinline__ unsigned cvt_pk_bf16(float lo, float hi) { unsigned r; asm volatile("v_cvt_pk_bf16_f32 %0, %1, %2" : "=v"(r) : "v"(lo), "v"(hi)); return r; }
template <class Epi, class Sched, bool ALIGN_EPI = false, bool SP2 = false>
__device__ __forceinline__ void gemm_phase(PG8_LAS unsigned char* lds, const Gemm g, const Sched& S, const Epi& E, int wave_s) {
    int tid_; { unsigned z_; asm volatile("s_mov_b32 %0, 0" : "=s"(z_)); tid_ = (wave_s << 6) | (int)__builtin_amdgcn_mbcnt_hi(~0u, __builtin_amdgcn_mbcnt_lo(~0u, z_)); }
    const int tid = tid_, wid = __builtin_amdgcn_readfirstlane(tid >> 6), lane = tid & 63, wr = wid >> 2, wc = wid & 3, fr = lane & 15, fq = lane >> 4;
    const int K = g.ld, nt = g.K / BK;
    unsigned voffA[2], voffB[2];
#pragma unroll
    for (int i = 0; i < 2; ++i) { int R, C; stage_rc(tid * 16 + i * 8192, R, C); const int Rb = Epi::PERM ? ((R & ~31) + perm32(R & 31)) : R;
        voffA[i] = (unsigned)(R * K + C) * 2u; voffB[i] = (unsigned)(Rb * K + C) * 2u; }
    const size_t kstep = (size_t)(BK * 2);
    const size_t hstep = (size_t)HALF * K * 2;
    const size_t tstep = 2 * hstep;
    const unsigned ldsw = (unsigned)wid * 1024u;
    const int aoff = lds_byte(wr * 64 + fr, fq * 8), boff = lds_byte(wc * 32 + fr, fq * 8);
#define PG8_SA(b, h) (((b) * 2 + (h)) * HTB)
#define PG8_SB(b, h) ((4 + (b) * 2 + (h)) * HTB)
#define PG8_STAGE(bufoff, gbase, voff) do { _Pragma("unroll") for (int _i = 0; _i < 2; ++_i) \
        __builtin_amdgcn_global_load_lds((const unsigned*)((const char*)(gbase) + (voff)[_i]), (PG8_LAS unsigned*)(lds + (bufoff) + ldsw + _i * 8192), 16, 0, 0); } while (0)
#define PG8_LDA(dst, b, h) do { _Pragma("unroll") for (int m = 0; m < 4; ++m) _Pragma("unroll") for (int k = 0; k < 2; ++k) dst[m][k] = *(const PG8_LAS bf16x8*)(lds + PG8_SA(b, h) + aoff + m * 2048 + k * 1024); } while (0)
#define PG8_LDB(dst, b, h) do { _Pragma("unroll") for (int n = 0; n < 2; ++n) _Pragma("unroll") for (int k = 0; k < 2; ++k) dst[n][k] = *(const PG8_LAS bf16x8*)(lds + PG8_SB(b, h) + boff + n * 2048 + k * 1024); } while (0)
#define PG8_MMA(ai, bj, At, Bt) do { __builtin_amdgcn_s_setprio(1); _Pragma("unroll") for (int m = 0; m < 4; ++m) _Pragma("unroll") for (int n = 0; n < 2; ++n) _Pragma("unroll") for (int k = 0; k < 2; ++k) \
        acc[ai][bj][m][n] = __builtin_amdgcn_mfma_f32_16x16x32_bf16(Bt[n][k], At[m][k], acc[ai][bj][m][n], 0, 0, 0); __builtin_amdgcn_s_setprio(0); } while (0)
#define PG8_WAIT_V(n) asm volatile("s_waitcnt vmcnt(" #n ")" ::: "memory")
#define PG8_WAIT_L(n) asm volatile("s_waitcnt lgkmcnt(" #n ")" ::: "memory")
#define PG8_BAR __builtin_amdgcn_s_barrier()
#define PG8_SCHED __builtin_amdgcn_sched_barrier(0)
    Unit cur, nxt; int ui = 0;
    if (!S.next(0, cur)) return;
    f32x4 acc[2][2][4][2];
#pragma unroll
    for (int a = 0; a < 2; ++a)
#pragma unroll
        for (int b = 0; b < 2; ++b)
#pragma unroll
            for (int m = 0; m < 4; ++m)
#pragma unroll
                for (int n = 0; n < 2; ++n) acc[a][b][m][n] = (f32x4){0.f, 0.f, 0.f, 0.f};
    bf16x8 At[4][2], B0[2][2], B1[2][2];
    const char* cA = (const char*)g.A + (size_t)cur.pm * tstep; const char* cB = (const char*)g.Bt + (size_t)cur.pn * tstep;
    S.a_ready(cur);
    if constexpr (SP2) {
        PG8_STAGE(PG8_SB(0, 0), cB, voffB); PG8_STAGE(PG8_SB(0, 1), cB + hstep, voffB); PG8_STAGE(PG8_SA(0, 0), cA, voffA); PG8_STAGE(PG8_SA(0, 1), cA + hstep, voffA);
        if (wr == 1) PG8_BAR;
        PG8_WAIT_V(2); PG8_BAR;
        PG8_STAGE(PG8_SB(1, 0), cB + kstep, voffB); PG8_STAGE(PG8_SA(1, 0), cA + kstep, voffA); PG8_STAGE(PG8_SB(1, 1), cB + hstep + kstep, voffB);
        PG8_WAIT_V(6); PG8_BAR;
    } else {
        PG8_STAGE(PG8_SB(0, 0), cB, voffB); PG8_STAGE(PG8_SA(0, 0), cA, voffA); PG8_STAGE(PG8_SB(0, 1), cB + hstep, voffB); PG8_STAGE(PG8_SA(0, 1), cA + hstep, voffA);
        if (wr == 1) PG8_BAR;
        PG8_WAIT_V(4); PG8_BAR;
        PG8_STAGE(PG8_SB(1, 0), cB + kstep, voffB); PG8_STAGE(PG8_SA(1, 0), cA + kstep, voffA); PG8_STAGE(PG8_SB(1, 1), cB + hstep + kstep, voffB);
        PG8_WAIT_V(6); PG8_BAR;
    }
    for (;;) {
        const bool has_next = S.next(ui + 1, nxt);
        const char* nA = has_next ? (const char*)g.A + (size_t)nxt.pm * tstep : cA; const char* nB = has_next ? (const char*)g.Bt + (size_t)nxt.pn * tstep : cB;
        for (int t = 0; t < nt; t += 2) {
            const bool last = (t == nt - 2);
            const char* a1 = cA + (size_t)(t + 1) * kstep;
            const char* a2 = last ? nA : cA + (size_t)(t + 2) * kstep; const char* b2 = last ? nB : cB + (size_t)(t + 2) * kstep;
            const char* a3 = a2 + kstep; const char* b3 = b2 + kstep;
            if (last && has_next) S.a_ready(nxt);
            if constexpr (SP2) {
            PG8_LDB(B0, 0, 0); PG8_LDB(B1, 0, 1); PG8_SCHED; PG8_LDA(At, 0, 0); PG8_STAGE(PG8_SA(1, 1), a1 + hstep, voffA);
            PG8_WAIT_V(8); PG8_WAIT_L(0); PG8_BAR; PG8_MMA(0, 0, At, B0); PG8_MMA(0, 1, At, B1); PG8_BAR; PG8_SCHED;
            PG8_LDA(At, 0, 1); PG8_STAGE(PG8_SB(0, 0), b2, voffB); PG8_STAGE(PG8_SB(0, 1), b2 + hstep, voffB); PG8_STAGE(PG8_SA(0, 0), a2, voffA);
            PG8_WAIT_V(8); PG8_WAIT_L(0); PG8_BAR; PG8_MMA(1, 0, At, B0); PG8_MMA(1, 1, At, B1); PG8_BAR; PG8_SCHED;
            PG8_LDB(B0, 1, 0); PG8_LDB(B1, 1, 1); PG8_SCHED; PG8_LDA(At, 1, 0); PG8_STAGE(PG8_SA(0, 1), a2 + hstep, voffA);
            PG8_WAIT_V(8); PG8_WAIT_L(0); PG8_BAR; PG8_MMA(0, 0, At, B0); PG8_MMA(0, 1, At, B1); PG8_BAR; PG8_SCHED;
            PG8_LDA(At, 1, 1); PG8_STAGE(PG8_SB(1, 0), b3, voffB); PG8_STAGE(PG8_SB(1, 1), b3 + hstep, voffB); PG8_STAGE(PG8_SA(1, 0), a3, voffA);
            PG8_WAIT_V(8); PG8_WAIT_L(0); PG8_BAR; PG8_MMA(1, 0, At, B0); PG8_MMA(1, 1, At, B1); PG8_BAR; PG8_SCHED;
            } else {
            PG8_LDB(B0, 0, 0); PG8_SCHED; PG8_LDA(At, 0, 0); PG8_STAGE(PG8_SA(1, 1), a1 + hstep, voffA);
            PG8_WAIT_L(8); PG8_BAR; PG8_WAIT_L(0); PG8_MMA(0, 0, At, B0); PG8_BAR; PG8_SCHED;
            PG8_LDB(B1, 0, 1); PG8_STAGE(PG8_SB(0, 0), b2, voffB);
            PG8_BAR; PG8_WAIT_L(0); PG8_MMA(0, 1, At, B1); PG8_BAR;
            PG8_LDA(At, 0, 1); PG8_STAGE(PG8_SA(0, 0), a2, voffA);
            PG8_BAR; PG8_WAIT_L(0); PG8_MMA(1, 0, At, B0); PG8_BAR; PG8_SCHED;
            PG8_STAGE(PG8_SB(0, 1), b2 + hstep, voffB);
            PG8_WAIT_V(6); PG8_BAR; PG8_MMA(1, 1, At, B1); PG8_BAR;
            PG8_LDB(B0, 1, 0); PG8_SCHED; PG8_LDA(At, 1, 0); PG8_STAGE(PG8_SA(0, 1), a2 + hstep, voffA);
            PG8_WAIT_L(8); PG8_BAR; PG8_WAIT_L(0); PG8_MMA(0, 0, At, B0); PG8_BAR; PG8_SCHED;
            PG8_LDB(B1, 1, 1); PG8_STAGE(PG8_SB(1, 0), b3, voffB);
            PG8_BAR; PG8_WAIT_L(0); PG8_MMA(0, 1, At, B1); PG8_BAR;
            PG8_LDA(At, 1, 1); PG8_STAGE(PG8_SA(1, 0), a3, voffA);
            PG8_BAR; PG8_WAIT_L(0); PG8_MMA(1, 0, At, B0); PG8_BAR; PG8_SCHED;
            PG8_STAGE(PG8_SB(1, 1), b3 + hstep, voffB);
            PG8_WAIT_V(6); PG8_BAR; PG8_MMA(1, 1, At, B1); PG8_BAR;
            }
        }
        if constexpr (ALIGN_EPI) { if (wr == 0) PG8_BAR; }
        if constexpr (!Epi::AFTER_DRAIN) { E(acc, cur, wr, wc, fr, fq); S.done(cur); }
        if (!has_next) break;
#pragma unroll
        for (int a = 0; a < 2; ++a)
#pragma unroll
            for (int b = 0; b < 2; ++b)
#pragma unroll
                for (int m = 0; m < 4; ++m)
#pragma unroll
                    for (int n = 0; n < 2; ++n) acc[a][b][m][n] = (f32x4){0.f, 0.f, 0.f, 0.f};
        cur = nxt; cA = nA; cB = nB; ++ui;
        if constexpr (ALIGN_EPI) { if (wr == 1) PG8_BAR; }
    }
    PG8_WAIT_V(0);
    if constexpr (!ALIGN_EPI) { if (wr == 0) PG8_BAR; }
    PG8_BAR;
    if constexpr (Epi::AFTER_DRAIN) { E.fused(acc, cur, wr, wc, fr, fq, lds, wid, lane); S.done(cur); }
#undef PG8_SA
#undef PG8_SB
#undef PG8_STAGE
#undef PG8_LDA
#undef PG8_LDB
#undef PG8_MMA
#undef PG8_WAIT_V
#undef PG8_WAIT_L
#undef PG8_BAR
#undef PG8_SCHED
}
}
using pg8::bf16_t; using pg8::bf16x8; using pg8::f32x4; using pg8::u32x4; using pg8::Unit;
typedef float f32x16 __attribute__((ext_vector_type(16)));
typedef unsigned u32x2 __attribute__((ext_vector_type(2)));
#define LAS __attribute__((address_space(3)))

constexpr int NLAT = 32768, NCTX = 4096, T = NLAT + NCTX, DM = 1024, FF = 2816, SEQ = 2048, CTXL = 256;
constexpr int NMODROW = 17, MODW = 9216;
constexpr float EPS = 1e-6f, LOG2E = 1.4426950408889634f, NEGV = -1e30f;
constexpr float SC64 = 0.125f * LOG2E, SC96 = 0.10206207261596577f * LOG2E;
constexpr int NWAVES = 8;

constexpr size_t MiB = 1u << 20;
constexpr size_t SZ_WGU = (size_t)5632 * 1024 * 2, SZ_WD = (size_t)1024 * 2816 * 2;
constexpr size_t OFF_WGU = 0, OFF_WD = OFF_WGU + 4 * SZ_WGU;
constexpr size_t OFF_WQK0 = OFF_WD + 4 * SZ_WD;
constexpr size_t OFF_WV0 = OFF_WQK0 + (size_t)1792 * 1024 * 2;
constexpr size_t OFF_WOUT0 = OFF_WV0 + (size_t)768 * 1024 * 2;
constexpr size_t OFF_WIN1 = OFF_WOUT0 + (size_t)1024 * 1024 * 2;
constexpr size_t OFF_WDV = OFF_WIN1 + (size_t)2304 * 1024 * 2;
constexpr size_t OFF_WOUT1 = OFF_WDV + (size_t)512 * 1024 * 2;
constexpr size_t OFF_WUQ = OFF_WOUT1 + (size_t)1024 * 1024 * 2;
constexpr size_t OFF_WUK = OFF_WUQ + (size_t)768 * 768 * 2;
constexpr size_t OFF_WUV = OFF_WUK + (size_t)512 * 256 * 2;
constexpr size_t OFF_CTL = 82 * MiB + 512 * 1024;
constexpr size_t OFF_MOD = 83 * MiB;
constexpr size_t OFF_ROPE64 = 85 * MiB, OFF_ROPE32 = OFF_ROPE64 + 64 * 16 * 8;
constexpr size_t OFF_GAIN = OFF_ROPE32 + 64 * 8 * 8;
constexpr size_t OFF_XCTX = 86 * MiB;
constexpr size_t OFF_H = 102 * MiB;
constexpr size_t OFF_Y = 174 * MiB;
constexpr size_t OFF_ACT = 246 * MiB;
constexpr size_t OFF_EXTRA = 444 * MiB;
constexpr size_t OFF_DVT = OFF_EXTRA;
constexpr size_t OFF_PQ = OFF_EXTRA + 36 * MiB;
constexpr size_t OFF_PKV = OFF_PQ + 2 * MiB;
constexpr size_t OFF_RS = OFF_PKV + 1 * MiB;
constexpr size_t OFF_BIAS = OFF_RS + 3 * MiB;
constexpr int BIAS_FFN = 0, BIAS_QK0 = 4 * 17 * 5632, BIAS_V0 = BIAS_QK0 + 17 * 1792, BIAS_IN1 = BIAS_V0 + 17 * 768, BIAS_DV = BIAS_IN1 + 17 * 2304, BIAS_END = BIAS_DV + 17 * 512;
constexpr size_t WS_END = OFF_BIAS + 2 * MiB;
static_assert((size_t)BIAS_END * 4 <= 2 * MiB, "bias tables");
constexpr size_t OFF_QK0 = OFF_ACT, OFF_VT0 = OFF_ACT + 126 * MiB;
constexpr size_t OFF_QK1 = OFF_ACT, OFF_CQ = OFF_ACT + 72 * MiB, OFF_CKV = OFF_ACT + 126 * MiB, OFF_KR = OFF_ACT + 144 * MiB, OFF_QC = OFF_ACT + 147 * MiB;
constexpr size_t OFF_KC = OFF_H, OFF_CVT = OFF_H + 36 * MiB;
static_assert(OFF_WUV + (size_t)512 * 256 * 2 <= OFF_CTL && WS_END <= 512 * MiB && OFF_QC + (size_t)NLAT * 768 * 2 <= OFF_ACT + 198 * MiB, "ws map");

constexpr int RING_BYTES = 131072, LDSCTL_OFF = 147456, LDS_BYTES = LDSCTL_OFF + 1024;

struct Params { const float* in[37]; float* out; unsigned char* ws; };
typedef const __attribute__((address_space(4))) Params* PP;

typedef float f32x2_t __attribute__((ext_vector_type(2))); typedef __bf16 bf16x2_t __attribute__((ext_vector_type(2)));
__device__ __forceinline__ unsigned pk2(float lo, float hi) { const f32x2_t v = {lo, hi}; return __builtin_bit_cast(unsigned, __builtin_convertvector(v, bf16x2_t)); }
__device__ __forceinline__ float max3f(float a, float b, float c) { float r; asm("v_max3_f32 %0, %1, %2, %3" : "=v"(r) : "v"(a), "v"(b), "v"(c)); return r; }
__device__ __forceinline__ float swap_max(float v) { auto rr = __builtin_amdgcn_permlane32_swap(__float_as_uint(v), __float_as_uint(v), false, false); return fmaxf(__uint_as_float(rr[0]), __uint_as_float(rr[1])); }
__device__ __forceinline__ float swap_sum(float v) { auto rr = __builtin_amdgcn_permlane32_swap(__float_as_uint(v), __float_as_uint(v), false, false); return __uint_as_float(rr[0]) + __uint_as_float(rr[1]); }
__device__ __forceinline__ float swap16_sum(float v) { auto rr = __builtin_amdgcn_permlane16_swap(__float_as_uint(v), __float_as_uint(v), false, false); return __uint_as_float(rr[0]) + __uint_as_float(rr[1]); }
__device__ __forceinline__ float wave_sum(float v, int lane) {
#pragma unroll
    for (int o = 1; o < 16; o <<= 1) v += __uint_as_float(__builtin_amdgcn_ds_bpermute((lane ^ o) << 2, __float_as_uint(v)));
    return swap_sum(swap16_sum(v));
}
__device__ __forceinline__ float silu_f(float x) { return x * __builtin_amdgcn_rcpf(1.0f + __builtin_amdgcn_exp2f(-x * LOG2E)); }
__device__ __forceinline__ int headperm(int H, int d) { return 256 * (H >> 2) + ((d < 32) ? (32 * (H & 3) + d) : (128 + 32 * (H & 3) + (d - 32))); }
__device__ __forceinline__ int r32perm(int d) { const int axis = d >> 4, half = (d >> 3) & 1, f = d & 7; return 16 * half + 4 * (axis * 2 + (f >> 2)) + (f & 3); }

__device__ __forceinline__ float row_rstd(const float* RS, int r) {
    const f32x4 a = *(const f32x4*)(RS + (size_t)r * 16), b = *(const f32x4*)(RS + (size_t)r * 16 + 4), c = *(const f32x4*)(RS + (size_t)r * 16 + 8), d = *(const f32x4*)(RS + (size_t)r * 16 + 12);
    return __builtin_amdgcn_rsqf((((a.x + a.y) + (a.z + a.w)) + ((b.x + b.y) + (b.z + b.w)) + ((c.x + c.y) + (c.z + c.w)) + ((d.x + d.y) + (d.z + d.w))) * (1.0f / DM) + EPS);
}
typedef const f32x4 (&AccRef)[2][2][4][2];

__device__ __forceinline__ void rows_rstd8(const float* RS, int r0, int fq, float (&rs)[8]) {
    f32x4 p[8];
#pragma unroll
    for (int i = 0; i < 8; ++i) p[i] = *(const f32x4*)(RS + (size_t)(r0 + (i >> 2) * 128 + (i & 3) * 16) * 16 + 4 * fq);
#pragma unroll
    for (int i = 0; i < 8; ++i) { const float s = swap_sum(swap16_sum((p[i].x + p[i].y) + (p[i].z + p[i].w))); rs[i] = __builtin_amdgcn_rsqf(s * (1.0f / DM) + EPS); }
}
struct EpiPlain {
    static constexpr bool PERM = true, AFTER_DRAIN = false;
    bf16_t* O; int ldc; const float* colpart; const float* RS; const float* bias; int nb;
    __device__ __forceinline__ void operator()(AccRef acc, const Unit& u, int wr, int wc, int fr, int fq) const {
        const int row0 = u.pm * 256 + wr * 64 + fr, col0 = u.pn * 256 + wc * 32 + 8 * fq;
        float cs[2][8];
#pragma unroll
        for (int bj = 0; bj < 2; ++bj)
#pragma unroll
            for (int e = 0; e < 8; ++e) {
                if (colpart) { const f32x4 p = *(const f32x4*)(colpart + (size_t)(col0 + bj * 128 + e) * 4); cs[bj][e] = __builtin_amdgcn_rsqf(((p.x + p.y) + (p.z + p.w)) * (1.0f / 256.0f) + EPS); }
                else cs[bj][e] = 1.0f;
            }
        if (RS) {
            const float mine = row_rstd(RS, col0 + (fr >> 3) * 128 + (fr & 7));
#pragma unroll
            for (int bj = 0; bj < 2; ++bj)
#pragma unroll
                for (int e = 0; e < 8; ++e) cs[bj][e] = __uint_as_float(__builtin_amdgcn_ds_bpermute((fq * 16 + bj * 8 + e) << 2, __float_as_uint(mine)));
        }
        const int ctok = u.pn * 256; const float* bp = bias ? bias + (size_t)(ctok < NLAT ? (ctok >> 11) : 16) * nb : nullptr;
#pragma unroll
        for (int ai = 0; ai < 2; ++ai)
#pragma unroll
            for (int m = 0; m < 4; ++m) {
                const int r = row0 + ai * 128 + m * 16; const float rb = bp ? bp[r] : 0.f;
                bf16_t* rowp = O + (size_t)r * ldc + col0;
#pragma unroll
                for (int bj = 0; bj < 2; ++bj) {
                    const f32x4 v0 = acc[ai][bj][m][0], v1 = acc[ai][bj][m][1];
                    u32x4 w; w.x = pk2(v0[0] * cs[bj][0] + rb, v0[1] * cs[bj][1] + rb); w.y = pk2(v0[2] * cs[bj][2] + rb, v0[3] * cs[bj][3] + rb);
                    w.z = pk2(v1[0] * cs[bj][4] + rb, v1[1] * cs[bj][5] + rb); w.w = pk2(v1[2] * cs[bj][6] + rb, v1[3] * cs[bj][7] + rb);
                    *(u32x4*)(rowp + bj * 128) = w;
                }
            }
    }
};

struct EpiSwiGLU {
    static constexpr bool PERM = true, AFTER_DRAIN = false;
    bf16_t* ACT; const float* RS; const float* bias;
    __device__ __forceinline__ void operator()(AccRef acc, const Unit& u, int wr, int wc, int fr, int fq) const {
        const int prow = u.pm * 256; const int row0 = prow + wr * 64 + fr, col0 = u.pn * 128 + wc * 32 + 8 * fq;
        const float* bp = bias + (size_t)(prow < NLAT ? (prow >> 11) : 16) * 5632 + u.pn * 256 + wc * 32 + 8 * fq;
        const f32x4 bg0 = *(const f32x4*)(bp), bg1 = *(const f32x4*)(bp + 4), bu0 = *(const f32x4*)(bp + 128), bu1 = *(const f32x4*)(bp + 132);
        float rsv[8]; rows_rstd8(RS, row0, fq, rsv);
#pragma unroll
        for (int ai = 0; ai < 2; ++ai)
#pragma unroll
            for (int m = 0; m < 4; ++m) {
                const int r = row0 + ai * 128 + m * 16; const float rs = rsv[ai * 4 + m];
                const f32x4 g0 = acc[ai][0][m][0] * rs + bg0, g1 = acc[ai][0][m][1] * rs + bg1, u0 = acc[ai][1][m][0] * rs + bu0, u1 = acc[ai][1][m][1] * rs + bu1;
                u32x4 w;
                w.x = pk2(silu_f(g0[0]) * u0[0], silu_f(g0[1]) * u0[1]); w.y = pk2(silu_f(g0[2]) * u0[2], silu_f(g0[3]) * u0[3]);
                w.z = pk2(silu_f(g1[0]) * u1[0], silu_f(g1[1]) * u1[1]); w.w = pk2(silu_f(g1[2]) * u1[2], silu_f(g1[3]) * u1[3]);
                *(u32x4*)(ACT + (size_t)r * FF + col0) = w;
                asm volatile("" ::: "memory");
            }
    }
};

struct EpiResid {
    static constexpr bool PERM = false, AFTER_DRAIN = false;
    const float* srcL; float* dstL; unsigned char* ws; int l, which, scn_l, scn_i; float gs;
    __device__ __forceinline__ void operator()(AccRef acc, const Unit& u, int wr, int wc, int fr_in, int fq_in) const {
        int fr = fr_in, fq = fq_in; asm volatile("" : "+v"(fr), "+v"(fq));
        const float* MODp = (const float*)(ws + OFF_MOD); const float* modl = MODp + (size_t)l * NMODROW * MODW;
        const float* scn = scn_i >= 0 ? MODp + (size_t)scn_l * NMODROW * MODW + scn_i * DM : nullptr;
        bf16_t* Hn = (bf16_t*)(ws + OFF_H); float* RS = (float*)(ws + OFF_RS); float* XCp = (float*)(ws + OFF_XCTX);
        const int row0 = u.pm * 256; const bool lat = row0 < NLAT; const int bidx = lat ? (row0 >> 11) : 16;
        const float* src = lat ? srcL + (size_t)row0 * DM : XCp + (size_t)(row0 - NLAT) * DM;
        float* dst = lat ? dstL + (size_t)row0 * DM : XCp + (size_t)(row0 - NLAT) * DM;
        const int col0 = u.pn * 256 + wc * 32 + 4 * fq;
        const float* gp = modl + (size_t)bidx * MODW + which * DM + col0;
        f32x4 gv[2][2], sv[2][2];
#pragma unroll
        for (int bj = 0; bj < 2; ++bj)
#pragma unroll
            for (int n = 0; n < 2; ++n) { gv[bj][n] = *(const f32x4*)(gp + bj * 128 + n * 16) * gs; sv[bj][n] = scn ? *(const f32x4*)(scn + (size_t)bidx * MODW + col0 + bj * 128 + n * 16) + 1.0f : (f32x4){0.f, 0.f, 0.f, 0.f}; }
#pragma unroll
        for (int g = 0; g < 4; ++g) {
            const int ai = g >> 1, m0 = (g & 1) * 2;
            f32x4 xb[2][2][2];
#pragma unroll
            for (int mm = 0; mm < 2; ++mm)
#pragma unroll
                for (int bj = 0; bj < 2; ++bj)
#pragma unroll
                    for (int n = 0; n < 2; ++n) xb[mm][bj][n] = *(const f32x4*)(src + (size_t)(ai * 128 + wr * 64 + (m0 + mm) * 16 + fr) * DM + col0 + bj * 128 + n * 16);
#pragma unroll
            for (int mm = 0; mm < 2; ++mm) {
                const int m = m0 + mm; const int rr = ai * 128 + wr * 64 + m * 16 + fr; const size_t off = (size_t)rr * DM + col0; float ss = 0.f;
#pragma unroll
                for (int bj = 0; bj < 2; ++bj)
#pragma unroll
                    for (int n = 0; n < 2; ++n) { const f32x4 o = xb[mm][bj][n] + gv[bj][n] * acc[ai][bj][m][n]; *(f32x4*)(dst + off + bj * 128 + n * 16) = o;
                        if (scn) { ss += (o[0] * o[0] + o[1] * o[1]) + (o[2] * o[2] + o[3] * o[3]); const f32x4 h = o * sv[bj][n]; u32x2 w; w.x = pk2(h[0], h[1]); w.y = pk2(h[2], h[3]);
                            *(u32x2*)(Hn + (size_t)(row0 + rr) * DM + col0 + bj * 128 + n * 16) = w; } }
                if (scn) { ss = swap_sum(swap16_sum(ss)); if (fq == 0) RS[(size_t)(row0 + rr) * 16 + u.pn * 4 + wc] = ss; }
            }
            asm volatile("" ::: "memory");
        }
    }
};

struct EpiResidAtomic {
    static constexpr bool PERM = false, AFTER_DRAIN = false;
    float* dstC; const float* modl; int which; float gs;
    __device__ __forceinline__ void operator()(AccRef acc, const Unit& u, int wr, int wc, int fr, int fq) const {
        float* dst = dstC + (size_t)(u.pm * 256) * DM; const int col0 = u.pn * 256 + wc * 32 + 4 * fq;
        const float* gp = modl + (size_t)16 * MODW + which * DM + col0;
        f32x4 gv[2][2];
#pragma unroll
        for (int bj = 0; bj < 2; ++bj)
#pragma unroll
            for (int n = 0; n < 2; ++n) gv[bj][n] = *(const f32x4*)(gp + bj * 128 + n * 16) * gs;
#pragma unroll
        for (int ai = 0; ai < 2; ++ai)
#pragma unroll
            for (int m = 0; m < 4; ++m) {
                float* rowp = dst + (size_t)(ai * 128 + wr * 64 + m * 16 + fr) * DM + col0;
#pragma unroll
                for (int bj = 0; bj < 2; ++bj)
#pragma unroll
                    for (int n = 0; n < 2; ++n) { const f32x4 v = gv[bj][n] * acc[ai][bj][m][n];
#pragma unroll
                        for (int e = 0; e < 4; ++e) (void)__hip_atomic_fetch_add(rowp + bj * 128 + n * 16 + e, v[e], __ATOMIC_RELAXED, __HIP_MEMORY_SCOPE_AGENT); }
            }
    }
};

__device__ __forceinline__ void head64_row(const f32x4 a00, const f32x4 a01, const f32x4 a10, const f32x4 a11, float rs, int fq, const float* gain, const float* rope64, bool do_rope, int p,
                                           float oscale, bf16_t* outp) {
    f32x4 v[2][2] = {{a00 * rs, a01 * rs}, {a10 * rs, a11 * rs}};
    float ss = 0.f;
#pragma unroll
    for (int bj = 0; bj < 2; ++bj)
#pragma unroll
        for (int n = 0; n < 2; ++n) ss += (v[bj][n][0] * v[bj][n][0] + v[bj][n][1] * v[bj][n][1]) + (v[bj][n][2] * v[bj][n][2] + v[bj][n][3] * v[bj][n][3]);
    ss = swap_sum(swap16_sum(ss));
    const float rstd = __builtin_amdgcn_rsqf(ss * (1.0f / 64.0f) + EPS);
#pragma unroll
    for (int bj = 0; bj < 2; ++bj)
#pragma unroll
        for (int n = 0; n < 2; ++n) v[bj][n] = v[bj][n] * rstd * *(const f32x4*)(gain + 32 * bj + 16 * n + 4 * fq);
    if (do_rope) {
#pragma unroll
        for (int bj = 0; bj < 2; ++bj) {
            const int pos = bj == 0 ? (p >> 6) : (p & 63);
            const f32x4 t0 = *(const f32x4*)(rope64 + (pos * 16 + 4 * fq) * 2), t1 = *(const f32x4*)(rope64 + (pos * 16 + 4 * fq) * 2 + 4);
            const f32x4 c = {t0[0], t0[2], t1[0], t1[2]}, s = {t0[1], t0[3], t1[1], t1[3]};
            const f32x4 x1 = v[bj][0], x2 = v[bj][1];
            v[bj][0] = x1 * c - x2 * s; v[bj][1] = x2 * c + x1 * s;
        }
    }
#pragma unroll
    for (int bj = 0; bj < 2; ++bj)
#pragma unroll
        for (int n = 0; n < 2; ++n) { const f32x4 o = v[bj][n] * oscale; u32x2 w; w.x = pk2(o[0], o[1]); w.y = pk2(o[2], o[3]); *(u32x2*)(outp + 32 * bj + 16 * n + 4 * fq) = w; }
}
__device__ __forceinline__ void head32_row(const f32x4 a0, const f32x4 a1, float rs, int fq, const float* gain, const float* rope32, bool do_rope, int p, float oscale, bf16_t* outp) {
    f32x4 v[2] = {a0 * rs, a1 * rs};
    float ss = (v[0][0] * v[0][0] + v[0][1] * v[0][1]) + (v[0][2] * v[0][2] + v[0][3] * v[0][3]) + (v[1][0] * v[1][0] + v[1][1] * v[1][1]) + (v[1][2] * v[1][2] + v[1][3] * v[1][3]);
    ss = swap_sum(swap16_sum(ss));
    const float rstd = __builtin_amdgcn_rsqf(ss * (1.0f / 32.0f) + EPS);
    const int axis = fq >> 1, fo = (fq & 1) * 4;
#pragma unroll
    for (int n = 0; n < 2; ++n) v[n] = v[n] * rstd * *(const f32x4*)(gain + axis * 16 + n * 8 + fo);
    if (do_rope) {
        const int pos = axis == 0 ? (p >> 6) : (p & 63);
        const f32x4 t0 = *(const f32x4*)(rope32 + (pos * 8 + fo) * 2), t1 = *(const f32x4*)(rope32 + (pos * 8 + fo) * 2 + 4);
        const f32x4 c = {t0[0], t0[2], t1[0], t1[2]}, s = {t0[1], t0[3], t1[1], t1[3]};
        const f32x4 x1 = v[0], x2 = v[1];
        v[0] = x1 * c - x2 * s; v[1] = x2 * c + x1 * s;
    }
#pragma unroll
    for (int n = 0; n < 2; ++n) { const f32x4 o = v[n] * oscale; u32x2 w; w.x = pk2(o[0], o[1]); w.y = pk2(o[2], o[3]); *(u32x2*)(outp + axis * 16 + n * 8 + fo) = w; }
}

struct EpiHeads0 {
    static constexpr bool PERM = false, AFTER_DRAIN = false;
    bf16_t* QK; const float* gains; const float* rope64; const float* RS; const float* bias;
    __device__ __forceinline__ void operator()(AccRef acc, const Unit& u, int wr, int wc, int fr, int fq) const {
        const int H = 4 * u.pn + wc; if (H >= 26) return;
        const float* gain = gains + (H >> 3) * 64; const float osc = H < 16 ? SC64 : 1.0f;
        const int row0 = u.pm * 256; const bool lat = row0 < NLAT;
        const float* bp = bias + (size_t)(lat ? (row0 >> 11) : 16) * 1792 + u.pn * 256 + wc * 32 + 4 * fq;
        const f32x4 b00 = *(const f32x4*)(bp), b01 = *(const f32x4*)(bp + 16), b10 = *(const f32x4*)(bp + 128), b11 = *(const f32x4*)(bp + 144);
        float rsv[8]; rows_rstd8(RS, row0 + wr * 64 + fr, fq, rsv);
#pragma unroll
        for (int ai = 0; ai < 2; ++ai)
#pragma unroll
            for (int m = 0; m < 4; ++m) { const int r = row0 + ai * 128 + wr * 64 + m * 16 + fr; const float rs = rsv[ai * 4 + m];
                head64_row(acc[ai][0][m][0] * rs + b00, acc[ai][0][m][1] * rs + b01, acc[ai][1][m][0] * rs + b10, acc[ai][1][m][1] * rs + b11, 1.0f, fq, gain, rope64, lat, r & 2047, osc, QK + (size_t)r * 1792 + H * 64); asm volatile("" ::: "memory"); }
    }
};

struct EpiHeads1 {
    static constexpr bool PERM = false, AFTER_DRAIN = false;
    bf16_t *QK, *CQ, *CKV, *KR; float *PQ, *PKV; const float *g_dq, *g_dk, *g_kr; const float* rope32; const float* RS; const float* bias;
    __device__ __forceinline__ void operator()(AccRef acc, const Unit& u, int wr, int wc, int fr, int fq) const {
        const int row0 = u.pm * 256; const bool lat = row0 < NLAT; const int pn = u.pn;
        if (pn == 8 && wc != 0) return;
        const float* bp = bias + (size_t)(lat ? (row0 >> 11) : 16) * 2304 + pn * 256 + wc * 32 + 4 * fq;
        const f32x4 b00 = *(const f32x4*)(bp), b01 = *(const f32x4*)(bp + 16), b10 = *(const f32x4*)(bp + 128), b11 = *(const f32x4*)(bp + 144);
        float rsv[8]; rows_rstd8(RS, row0 + wr * 64 + fr, fq, rsv);
        if (pn < 4) {
            const int H = 4 * pn + wc; const float* gain = H < 8 ? g_dq : g_dk; const float osc = H < 8 ? SC64 : 1.0f;
#pragma unroll
            for (int ai = 0; ai < 2; ++ai)
#pragma unroll
                for (int m = 0; m < 4; ++m) { const int r = row0 + ai * 128 + wr * 64 + m * 16 + fr; const float rs = rsv[ai * 4 + m];
                    head64_row(acc[ai][0][m][0] * rs + b00, acc[ai][0][m][1] * rs + b01, acc[ai][1][m][0] * rs + b10, acc[ai][1][m][1] * rs + b11, 1.0f, fq, gain, nullptr, false, 0, osc, QK + (size_t)r * 1024 + H * 64); asm volatile("" ::: "memory"); }
        } else if (pn < 8) {
            bf16_t* O = pn < 7 ? CQ : CKV; const int ldc = pn < 7 ? 768 : 256; const int colt = pn < 7 ? (pn - 4) * 256 : 0;
            float* Pp = pn < 7 ? PQ : PKV; const int pst = pn < 7 ? 12 : 4, pix = pn < 7 ? (pn - 4) * 4 + wc : wc;
#pragma unroll
            for (int ai = 0; ai < 2; ++ai)
#pragma unroll
                for (int m = 0; m < 4; ++m) { const int r = row0 + ai * 128 + wr * 64 + m * 16 + fr; const float rs = rsv[ai * 4 + m]; float ss = 0.f;
#pragma unroll
                    for (int bj = 0; bj < 2; ++bj)
#pragma unroll
                        for (int n = 0; n < 2; ++n) { const f32x4 v = acc[ai][bj][m][n] * rs + (bj == 0 ? (n == 0 ? b00 : b01) : (n == 0 ? b10 : b11)); ss += (v[0] * v[0] + v[1] * v[1]) + (v[2] * v[2] + v[3] * v[3]);
                            u32x2 w; w.x = pk2(v[0], v[1]); w.y = pk2(v[2], v[3]); *(u32x2*)(O + (size_t)r * ldc + colt + bj * 128 + wc * 32 + n * 16 + 4 * fq) = w; }
                    ss = swap_sum(swap16_sum(ss));
                    if (fq == 0) Pp[(size_t)r * pst + pix] = ss; asm volatile("" ::: "memory"); }
        } else {
#pragma unroll
            for (int ai = 0; ai < 2; ++ai)
#pragma unroll
                for (int m = 0; m < 4; ++m) { const int r = row0 + ai * 128 + wr * 64 + m * 16 + fr; const float rs = rsv[ai * 4 + m];
                    head32_row(acc[ai][0][m][0] * rs + b00, acc[ai][0][m][1] * rs + b01, 1.0f, fq, g_kr, rope32, lat, r & 2047, 1.0f, KR + (size_t)r * 32); asm volatile("" ::: "memory"); }
        }
    }
};

struct EpiUq {
    static constexpr bool PERM = false, AFTER_DRAIN = false;
    bf16_t* QC; const float* PQ; const float *g_nope, *g_rope; const float* rope32;
    __device__ __forceinline__ void operator()(AccRef acc, const Unit& u, int wr, int wc, int fr, int fq) const {
        const int row0 = u.pm * 256;
#pragma unroll
        for (int ai = 0; ai < 2; ++ai)
#pragma unroll
            for (int m = 0; m < 4; ++m) { const int r = row0 + ai * 128 + wr * 64 + m * 16 + fr;
                const f32x4 p0 = *(const f32x4*)(PQ + (size_t)r * 12), p1 = *(const f32x4*)(PQ + (size_t)r * 12 + 4), p2 = *(const f32x4*)(PQ + (size_t)r * 12 + 8);
                const float rs = __builtin_amdgcn_rsqf((((p0.x + p0.y) + (p0.z + p0.w)) + ((p1.x + p1.y) + (p1.z + p1.w)) + ((p2.x + p2.y) + (p2.z + p2.w))) * (1.0f / 768.0f) + EPS);
                if (u.pn < 2) { const int H = 4 * u.pn + wc;
                    head64_row(acc[ai][0][m][0], acc[ai][0][m][1], acc[ai][1][m][0], acc[ai][1][m][1], rs, fq, g_nope, nullptr, false, 0, SC96, QC + (size_t)r * 768 + H * 96); }
                else {
#pragma unroll
                    for (int bj = 0; bj < 2; ++bj) head32_row(acc[ai][bj][m][0], acc[ai][bj][m][1], rs, fq, g_rope, rope32, true, r & 2047, SC96, QC + (size_t)r * 768 + (4 * bj + wc) * 96 + 64); }
                asm volatile("" ::: "memory");
            }
    }
};

struct EpiUk {
    static constexpr bool PERM = false, AFTER_DRAIN = false;
    bf16_t* KC; const float* PKV; const float* g_nope;
    __device__ __forceinline__ void operator()(AccRef acc, const Unit& u, int wr, int wc, int fr, int fq) const {
        const int row0 = u.pm * 256; const int H = 4 * u.pn + wc;
#pragma unroll
        for (int ai = 0; ai < 2; ++ai)
#pragma unroll
            for (int m = 0; m < 4; ++m) { const int r = row0 + ai * 128 + wr * 64 + m * 16 + fr;
                const f32x4 p = *(const f32x4*)(PKV + (size_t)r * 4);
                const float rs = __builtin_amdgcn_rsqf(((p.x + p.y) + (p.z + p.w)) * (1.0f / 256.0f) + EPS);
                head64_row(acc[ai][0][m][0], acc[ai][0][m][1], acc[ai][1][m][0], acc[ai][1][m][1], rs, fq, g_nope, nullptr, false, 0, 1.0f, KC + (size_t)r * 512 + H * 64); asm volatile("" ::: "memory"); }
    }
};

struct OffOrder : pg8::StaticOrder {
    int p0;
    __device__ __forceinline__ bool next(int i, Unit& u) const { if (!pg8::StaticOrder::next(i, u)) return false; u.pm += p0; return true; }
};
template <class Epi> __device__ __forceinline__ void run_gemm(PG8_LAS unsigned char* lds, int wave_s, const bf16_t* A, const bf16_t* Bt, int M, int N, int K, const Epi& E, int rot = 0, int p0 = 0, int Gs = 0, int cs = -1) {
    int G = (int)gridDim.x, c = (int)blockIdx.x;
    if (Gs > 0) { G = Gs; c = cs; if (c < 0 || c >= G) return; }
    c += rot; c = c >= G ? c - G : c;
    pg8::Gemm g{A, Bt, M, N, K, K}; OffOrder S; S.init(M, N, G, c); S.p0 = p0;
    pg8::gemm_phase<Epi, OffOrder, true, true>(lds, g, S, E, wave_s);
}

__device__ __forceinline__ bf16_t* dst_row(unsigned char* ws, int mat, int n) {
    if (mat < 12) { const int l = mat / 6, f = (mat % 6) / 3, k = mat % 3, idx = l * 2 + f;
        if (k == 2) return (bf16_t*)(ws + OFF_WD + idx * SZ_WD) + (size_t)n * FF;
        return (bf16_t*)(ws + OFF_WGU + idx * SZ_WGU) + (size_t)(256 * (n >> 7) + (n & 127) + (k == 1 ? 128 : 0)) * DM; }
    if (mat == 12) {
        bf16_t* qk = (bf16_t*)(ws + OFF_WQK0); bf16_t* wv = (bf16_t*)(ws + OFF_WV0);
        if (n < 1024) return qk + (size_t)headperm(n >> 6, n & 63) * DM;
        if (n < 1152) return qk + (size_t)headperm(24 + ((n - 1024) >> 6), n & 63) * DM;
        if (n < 1280) return wv + (size_t)(n - 1152) * DM;
        if (n < 1792) return qk + (size_t)headperm(16 + ((n - 1280) >> 6), n & 63) * DM;
        return wv + (size_t)(128 + n - 1792) * DM;
    }
    if (mat == 13) return (bf16_t*)(ws + OFF_WOUT0) + (size_t)n * DM;
    if (mat == 14) {
        bf16_t* w = (bf16_t*)(ws + OFF_WIN1);
        if (n < 768) return w + (size_t)(1024 + n) * DM;
        if (n < 1280) return w + (size_t)headperm((n - 768) >> 6, n & 63) * DM;
        if (n < 1536) return w + (size_t)(1792 + n - 1280) * DM;
        if (n < 1568) return w + (size_t)(2048 + r32perm(n - 1536)) * DM;
        if (n < 2080) return w + (size_t)headperm(8 + ((n - 1568) >> 6), (n - 1568) & 63) * DM;
        return (bf16_t*)(ws + OFF_WDV) + (size_t)(n - 2080) * DM;
    }
    if (mat == 15) return (bf16_t*)(ws + OFF_WOUT1) + (size_t)n * DM;
    if (mat == 16) { const int h = n / 96, dd = n % 96; bf16_t* w = (bf16_t*)(ws + OFF_WUQ);
        if (dd < 64) return w + (size_t)headperm(h, dd) * 768;
        return w + (size_t)(512 + 128 * (h >> 2) + 32 * (h & 3) + r32perm(dd - 64)) * 768; }
    { const int h = n >> 7, dd = n & 127;
      if (dd < 64) return (bf16_t*)(ws + OFF_WUK) + (size_t)headperm(h, dd) * 256;
      return (bf16_t*)(ws + OFF_WUV) + (size_t)(h * 64 + dd - 64) * 256; }
}
__device__ __forceinline__ void transpose_item(const float* W, int K, int N, const float* kgain, unsigned char* ws, int mat, LAS float* scr, int item, int lane) {
    const int nblk = N / 32, kb = item / nblk, nb = item % nblk, k0 = 64 * kb, n0 = 32 * nb;
#pragma unroll 8
    for (int i = 0; i < 32; ++i) { const int kk = 2 * i + (lane >> 5); float v = W[(size_t)(k0 + kk) * N + n0 + (lane & 31)]; if (kgain) v *= kgain[k0 + kk]; scr[kk * 33 + (lane & 31)] = v; }
    asm volatile("s_waitcnt lgkmcnt(0)" ::: "memory");
    const int c = lane & 7;
#pragma unroll
    for (int j = 0; j < 4; ++j) { const int n = (lane >> 3) + 8 * j; const LAS float* s = scr + (8 * c) * 33 + n;
        u32x4 o; o.x = pk2(s[0 * 33], s[1 * 33]); o.y = pk2(s[2 * 33], s[3 * 33]); o.z = pk2(s[4 * 33], s[5 * 33]); o.w = pk2(s[6 * 33], s[7 * 33]);
        *(u32x4*)(dst_row(ws, mat, n0 + n) + k0 + 8 * c) = o; }
    asm volatile("s_waitcnt lgkmcnt(0)" ::: "memory");
}
__device__ __forceinline__ void sincos_d(double x, double& s, double& c) {
    const double k = __builtin_rint(x * 0.63661977236758134308); const double r = (x - k * 1.57079632679489655800) - k * 6.123233995736766036e-17; const double r2 = r * r;
    double sp = r * (1.0 + r2 * (-1.0 / 6 + r2 * (1.0 / 120 + r2 * (-1.0 / 5040 + r2 * (1.0 / 362880 + r2 * (-1.0 / 39916800 + r2 * (1.0 / 6227020800.0 + r2 * (-1.0 / 1307674368000.0))))))));
    double cp = 1.0 + r2 * (-0.5 + r2 * (1.0 / 24 + r2 * (-1.0 / 720 + r2 * (1.0 / 40320 + r2 * (-1.0 / 3628800 + r2 * (1.0 / 479001600.0 + r2 * (-1.0 / 87178291200.0 + r2 * (1.0 / 20922789888000.0))))))));
    const int q = ((int)k) & 3;
    s = (q == 0) ? sp : (q == 1) ? cp : (q == 2) ? -sp : -cp;
    c = (q == 0) ? cp : (q == 1) ? -sp : (q == 2) ? -cp : sp;
}
__device__ __forceinline__ int phase_tid(int wave_s) { unsigned z_; asm volatile("s_mov_b32 %0, 0" : "=s"(z_)); return (wave_s << 6) | (int)__builtin_amdgcn_mbcnt_hi(~0u, __builtin_amdgcn_mbcnt_lo(~0u, z_)); }
__device__ __forceinline__ void prologue(PP P, LAS unsigned char* lds, int wave_s) {
    const int tid = phase_tid(wave_s), lane = tid & 63, wave = wave_s;
    unsigned char* ws = P->ws;
    if (blockIdx.x == 0) {
        for (int i = tid; i < 64 * 16 + 64 * 8; i += 512) {
            const bool big = i < 1024; const int j = big ? i : i - 1024; const int nf = big ? 16 : 8, pos = j / nf, f = j % nf;
            const float inv = __builtin_amdgcn_exp2f(-(float)f / (float)nf * 13.287712379549449f);
            const float ang = (float)pos * inv; double s, c; sincos_d((double)ang, s, c);
            float* dst = (float*)(ws + (big ? OFF_ROPE64 : OFF_ROPE32)) + 2 * j; dst[0] = (float)c; dst[1] = (float)s;
        }
    }
    if (blockIdx.x == 1) {
        float* G = (float*)(ws + OFF_GAIN);
        if (tid < 64) G[tid] = P->in[14][tid]; else if (tid < 128) G[tid] = P->in[17][tid - 64]; else if (tid < 192) G[tid] = P->in[18][tid - 128]; else if (tid < 256) G[tid] = P->in[15][tid - 192];
    }
    {
        LAS float* act = (LAS float*)lds;
        LAS float* red = (LAS float*)(lds + 17 * 1024 * 4);
        for (int i = tid; i < 17 * 1024; i += 512) { const float v = i < 16 * 1024 ? P->in[1][i] : P->in[3][i - 16 * 1024]; act[i] = silu_f(v); }
        __syncthreads();
        float* MOD = (float*)(ws + OFF_MOD);
        for (int item = blockIdx.x; item < 2 * 144; item += gridDim.x) {
            const int l = item / 144, n0 = (item % 144) * 64, col = tid & 63, ks = tid >> 6;
            const float* w = P->in[4] + (size_t)l * DM * MODW + (size_t)(ks * 128) * MODW + n0 + col;
            float a[17];
#pragma unroll
            for (int j = 0; j < 17; ++j) a[j] = 0.f;
            for (int k = 0; k < 128; k += 4) {
                const float w0 = w[(size_t)k * MODW], w1 = w[(size_t)(k + 1) * MODW], w2 = w[(size_t)(k + 2) * MODW], w3 = w[(size_t)(k + 3) * MODW];
#pragma unroll
                for (int j = 0; j < 17; ++j) { const f32x4 x = *(const LAS f32x4*)(act + j * 1024 + ks * 128 + k); a[j] += (x[0] * w0 + x[1] * w1) + (x[2] * w2 + x[3] * w3); }
            }
#pragma unroll
            for (int j = 0; j < 17; ++j) red[(ks * 17 + j) * 64 + col] = a[j];
            __syncthreads();
            for (int i = tid; i < 17 * 64; i += 512) { const int j = i >> 6, cc = i & 63; float s = 0.f;
#pragma unroll
                for (int q = 0; q < 8; ++q) s += red[(q * 17 + j) * 64 + cc];
                MOD[((size_t)l * 17 + j) * MODW + n0 + cc] = s + P->in[5][(size_t)l * MODW + n0 + cc]; }
            __syncthreads();
        }
        __syncthreads();
    }
    {
        LAS float* scr = (LAS float*)(lds + wave * 16384);
        const int gw = blockIdx.x * NWAVES + wave, NGW = gridDim.x * NWAVES;
        constexpr int I_GU = 16 * 88, I_D = 44 * 32, I_ABIN = 16 * 72, I_O = 16 * 32, I_CDIN = 16 * 81, I_UQ = 12 * 24, I_UKV = 4 * 32;
        constexpr int NITEMS = 8 * I_GU + 4 * I_D + I_ABIN + 2 * I_O + I_CDIN + I_UQ + I_UKV;
        for (int it = gw; it < NITEMS; it += NGW) {
            int r = it;
            if (r < 12 * I_GU) {
                const int mat = r / I_GU, l = mat / 6, f = (mat % 6) / 3, k = mat % 3; r -= mat * I_GU;
                const float* src = P->in[6 + f * 3 + k] + (size_t)l * DM * FF;
                if (k == 2) transpose_item(src, FF, DM, nullptr, ws, mat, scr, r, lane); else transpose_item(src, DM, FF, nullptr, ws, mat, scr, r, lane);
                continue;
            }
            r -= 12 * I_GU;
            if (r < I_ABIN) { transpose_item(P->in[12], DM, 2304, nullptr, ws, 12, scr, r, lane); continue; } r -= I_ABIN;
            if (r < I_O) { transpose_item(P->in[13], DM, DM, nullptr, ws, 13, scr, r, lane); continue; } r -= I_O;
            if (r < I_CDIN) { transpose_item(P->in[24], DM, 2592, nullptr, ws, 14, scr, r, lane); continue; } r -= I_CDIN;
            if (r < I_O) { transpose_item(P->in[25], DM, DM, nullptr, ws, 15, scr, r, lane); continue; } r -= I_O;
            if (r < I_UQ) { transpose_item(P->in[28], 768, 768, P->in[26], ws, 16, scr, r, lane); continue; } r -= I_UQ;
            transpose_item(P->in[29], 256, 1024, P->in[27], ws, 17, scr, r, lane);
        }
    }
}
static_assert(16 * 88 == 44 * 32, "item counts");

__device__ __forceinline__ void prep_phase(PP P, LAS unsigned char* lds, int wave_s) {
    const int tid = phase_tid(wave_s), lane = tid & 63, wave = wave_s;
    unsigned char* ws = P->ws; const float* MOD = (const float*)(ws + OFF_MOD); float* BIAS = (float*)(ws + OFF_BIAS);
    LAS float* sh = (LAS float*)lds;
    for (int vb = blockIdx.x; vb < 256; vb += gridDim.x) {
        int c, i0, cnt;
        if (vb < 52) { c = 0; i0 = vb; cnt = 52; } else if (vb < 75) { c = 1; i0 = vb - 52; cnt = 23; } else if (vb < 127) { c = 2; i0 = vb - 75; cnt = 52; }
        else if (vb < 179) { c = 3; i0 = vb - 127; cnt = 52; } else if (vb < 204) { c = 4; i0 = vb - 179; cnt = 25; } else { c = 5; i0 = vb - 204; cnt = 52; }
        const int l = c / 3, kind = c % 3, a = kind * 3;
        __syncthreads();
        for (int i = tid; i < 17 * 1024; i += 512) sh[i] = MOD[((size_t)l * 17 + (i >> 10)) * MODW + a * DM + (i & 1023)];
        __syncthreads();
        const int ntot = kind != 1 ? 5632 : (l == 0 ? 2560 : 2816);
        for (int n = i0 * 8 + wave; n < ntot; n += cnt * 8) {
            const bf16_t* wrow; float* bout; int nb, nn;
            if (kind != 1) { wrow = (const bf16_t*)(ws + OFF_WGU + (size_t)(l * 2 + (kind >> 1)) * SZ_WGU) + (size_t)n * DM; bout = BIAS + BIAS_FFN + (l * 2 + (kind >> 1)) * 17 * 5632; nb = 5632; nn = n; }
            else if (l == 0) { if (n < 1792) { wrow = (const bf16_t*)(ws + OFF_WQK0) + (size_t)n * DM; bout = BIAS + BIAS_QK0; nb = 1792; nn = n; } else { wrow = (const bf16_t*)(ws + OFF_WV0) + (size_t)(n - 1792) * DM; bout = BIAS + BIAS_V0; nb = 768; nn = n - 1792; } }
            else { if (n < 2304) { wrow = (const bf16_t*)(ws + OFF_WIN1) + (size_t)n * DM; bout = BIAS + BIAS_IN1; nb = 2304; nn = n; } else { wrow = (const bf16_t*)(ws + OFF_WDV) + (size_t)(n - 2304) * DM; bout = BIAS + BIAS_DV; nb = 512; nn = n - 2304; } }
            float acc[17];
#pragma unroll
            for (int j = 0; j < 17; ++j) acc[j] = 0.f;
            u32x2 wq[4];
#pragma unroll
            for (int q = 0; q < 4; ++q) wq[q] = *(const u32x2*)(wrow + q * 256 + 4 * lane);
#pragma unroll
            for (int q = 0; q < 4; ++q) {
                const u32x2 wv = wq[q];
                const float w0 = __uint_as_float(wv.x << 16), w1 = __uint_as_float(wv.x & 0xffff0000u), w2 = __uint_as_float(wv.y << 16), w3 = __uint_as_float(wv.y & 0xffff0000u);
#pragma unroll
                for (int j = 0; j < 17; ++j) { const f32x4 s = *(const LAS f32x4*)(sh + j * 1024 + q * 256 + 4 * lane); acc[j] += (s[0] * w0 + s[1] * w1) + (s[2] * w2 + s[3] * w3); }
                asm volatile("" ::: "memory");
            }
#pragma unroll
            for (int j = 0; j < 17; ++j) acc[j] = wave_sum(acc[j], lane);
            if (lane == 0) {
#pragma unroll
                for (int j = 0; j < 17; ++j) bout[(size_t)j * nb + nn] = acc[j];
            }
        }
    }
    {
        const float* mod0 = MOD; bf16_t* H = (bf16_t*)(ws + OFF_H); float* RS = (float*)(ws + OFF_RS); float* XC = (float*)(ws + OFF_XCTX);
        const int gw = blockIdx.x * NWAVES + wave, NGW = gridDim.x * NWAVES;
        for (int row = gw; row < T; row += NGW) {
            const bool lat = row < NLAT; const int bidx = lat ? (row >> 11) : 16;
            const f32x4* xr = (const f32x4*)(lat ? P->in[0] + (size_t)row * DM : P->in[2] + (size_t)(row - NLAT) * DM) + lane;
            const f32x4* sc = (const f32x4*)(mod0 + (size_t)bidx * MODW + DM) + lane;
            f32x4 v[4]; float s = 0.f;
#pragma unroll
            for (int j = 0; j < 4; ++j) { v[j] = xr[64 * j]; s += (v[j][0] * v[j][0] + v[j][1] * v[j][1]) + (v[j][2] * v[j][2] + v[j][3] * v[j][3]); }
            if (!lat) { f32x4* xc = (f32x4*)(XC + (size_t)(row - NLAT) * DM) + lane;
#pragma unroll
                for (int j = 0; j < 4; ++j) xc[64 * j] = v[j]; }
            s = wave_sum(s, lane);
            if (lane < 16) RS[(size_t)row * 16 + lane] = lane == 0 ? s : 0.f;
            u32x2* o = (u32x2*)(H + (size_t)row * DM) + lane;
#pragma unroll
            for (int j = 0; j < 4; ++j) { const f32x4 r = v[j] * (sc[64 * j] + 1.0f); u32x2 w; w.x = pk2(r[0], r[1]); w.y = pk2(r[2], r[3]); o[64 * j] = w; }
        }
    }
}


struct AttnArgs {
    const bf16_t* q;
    const bf16_t* k0; int ld0;
    const bf16_t* k1;
    const bf16_t* vt;
    int ctx_tok, lat_tok, t_lo, t_hi;
    int w_lo, w_hi;
    int qpos;
    int qrow;
    const float* rpb;
};
constexpr int KSTR64 = 144, KSTR96 = 208, VSTR = 144;
constexpr int A_KB = 13312, A_VB = 18432, A_K0 = 0, A_V0 = 2 * A_KB, A_STASH = 2 * A_KB + 3 * A_VB;
static_assert(A_STASH + 8 * 8192 <= LDSCTL_OFF, "attention LDS map");
__device__ __forceinline__ void lds_rd128(bf16x8& d, unsigned addr, int off) { asm volatile("ds_read_b128 %0, %1 offset:%c2" : "=&v"(d) : "v"(addr), "i"(off) : "memory"); }
template <int N> __device__ __forceinline__ void lds_wait(bf16x8& a, bf16x8& b) { asm volatile("s_waitcnt lgkmcnt(%c2)" : "+v"(a), "+v"(b) : "i"(N) : "memory"); }
template <int N> __device__ __forceinline__ void lds_wait(bf16x8& a, bf16x8& b, bf16x8& c, bf16x8& d) { asm volatile("s_waitcnt lgkmcnt(%c4)" : "+v"(a), "+v"(b), "+v"(c), "+v"(d) : "i"(N) : "memory"); }
template <int NDB> __device__ __forceinline__ void pv_tile(f32x16 (&o)[NDB], unsigned va, const u32x4 (&pw)[4]) {
    if constexpr (NDB == 2) {
        bf16x8 v[4][2];
#pragma unroll
        for (int s = 0; s < 4; ++s)
#pragma unroll
            for (int db = 0; db < 2; ++db) lds_rd128(v[s][db], va, (32 * db) * VSTR + 32 * s);
        lds_wait<4>(v[0][0], v[0][1], v[1][0], v[1][1]);
#pragma unroll
        for (int s = 0; s < 2; ++s)
#pragma unroll
            for (int db = 0; db < 2; ++db) o[db] = __builtin_amdgcn_mfma_f32_32x32x16_bf16(v[s][db], __builtin_bit_cast(bf16x8, pw[s]), o[db], 0, 0, 0);
        lds_wait<0>(v[2][0], v[2][1], v[3][0], v[3][1]);
#pragma unroll
        for (int s = 2; s < 4; ++s)
#pragma unroll
            for (int db = 0; db < 2; ++db) o[db] = __builtin_amdgcn_mfma_f32_32x32x16_bf16(v[s][db], __builtin_bit_cast(bf16x8, pw[s]), o[db], 0, 0, 0);
    } else {
#pragma unroll
        for (int s0 = 0; s0 < 4; s0 += 2) {
            bf16x8 v[2][4];
#pragma unroll
            for (int s = 0; s < 2; ++s)
#pragma unroll
                for (int db = 0; db < 4; ++db) lds_rd128(v[s][db], va, (32 * db) * VSTR + 32 * (s0 + s));
            lds_wait<4>(v[0][0], v[0][1], v[0][2], v[0][3]);
#pragma unroll
            for (int db = 0; db < 4; ++db) o[db] = __builtin_amdgcn_mfma_f32_32x32x16_bf16(v[0][db], __builtin_bit_cast(bf16x8, pw[s0]), o[db], 0, 0, 0);
            lds_wait<0>(v[1][0], v[1][1], v[1][2], v[1][3]);
#pragma unroll
            for (int db = 0; db < 4; ++db) o[db] = __builtin_amdgcn_mfma_f32_32x32x16_bf16(v[1][db], __builtin_bit_cast(bf16x8, pw[s0 + 1]), o[db], 0, 0, 0);
        }
    }
}
template <int NS, int NDB, int MODE>
__device__ __forceinline__ void attn_run(f32x16 (&o)[NDB], float& mrun, float& lrun, const AttnArgs& A, LAS unsigned char* lds, int tid, int r32, int hi) {
    constexpr int KSTR = NS == 6 ? KSTR96 : KSTR64;
    const int pi = (r32 & 0x13) | ((r32 & 4) << 1) | ((r32 & 8) >> 1);
    bf16x8 qf[NS];
#pragma unroll
    for (int s = 0; s < NS; ++s) qf[s] = *(const bf16x8*)(A.q + 16 * s);
    const int ntile = 4 + (A.t_hi - A.t_lo);
    u32x4 sk, sk1, sv[NDB / 2];
    const int srow = tid >> 3, sch = tid & 7;
    const int koffl = (srow * A.ld0 + sch * 8) * 2, voffl = (srow * T + sch * 8) * 2, k1offl = ((tid >> 2) * 32 + (tid & 3) * 8) * 2;
    const __amdgpu_buffer_rsrc_t rk = __builtin_amdgcn_make_buffer_rsrc((void*)A.k0, (short)0, 0x7fffffff, 0x00020000);
    const __amdgpu_buffer_rsrc_t rv = __builtin_amdgcn_make_buffer_rsrc((void*)A.vt, (short)0, 0x7fffffff, 0x00020000);
    const __amdgpu_buffer_rsrc_t rk1 = __builtin_amdgcn_make_buffer_rsrc((void*)(NS == 6 ? A.k1 : A.k0), (short)0, 0x7fffffff, 0x00020000);
#define ATT_LOAD(tok) do { sk = __builtin_amdgcn_raw_buffer_load_b128(rk, koffl, (tok) * A.ld0 * 2, 0); \
        if (NS == 6) { if (tid < 256) sk1 = __builtin_amdgcn_raw_buffer_load_b128(rk1, k1offl, (tok) * 64, 0); } \
        _Pragma("unroll") for (int p = 0; p < NDB / 2; ++p) sv[p] = __builtin_amdgcn_raw_buffer_load_b128(rv, voffl, (p * 64 * T + (tok)) * 2, 0); } while (0)
#define ATT_WRITE(b, vb3) do { *(LAS u32x4*)(lds + A_K0 + (b) * A_KB + srow * KSTR + sch * 16) = sk; \
        if (NS == 6) { if (tid < 256) *(LAS u32x4*)(lds + A_K0 + (b) * A_KB + (tid >> 2) * KSTR + 128 + (tid & 3) * 16) = sk1; } \
        _Pragma("unroll") for (int p = 0; p < NDB / 2; ++p) *(LAS u32x4*)(lds + A_V0 + (vb3) * A_VB + (p * 64 + srow) * VSTR + sch * 16) = sv[p]; } while (0)
    ATT_LOAD(A.ctx_tok);
    const int kro = pi * KSTR + 16 * hi, vro = r32 * VSTR + 16 * hi;
    const int grp = __builtin_amdgcn_readfirstlane(tid >> 8);
    u32x4 pw[4]; bool have_prev = false; int vb3 = 0;
    f32x16 negm;
#pragma unroll
    for (int i = 0; i < 16; ++i) negm[i] = -mrun;
    const int q0w = MODE == 1 ? __builtin_amdgcn_readfirstlane(A.qpos - r32) : 0;
    float pen0[16], pen1[16];
    if (MODE == 2) { const int cs = min(max(A.qpos - 8, 0), 48);
#pragma unroll
        for (int i = 0; i < 16; ++i) { const int kc = 8 * hi + (i & 7) + 16 * (i >> 3); pen0[i] = ((unsigned)(kc - cs) < 16u) ? 0.f : NEGV; pen1[i] = ((unsigned)(kc + 32 - cs) < 16u) ? 0.f : NEGV; } }
#define ATT_PV(vbi) pv_tile<NDB>(o, (unsigned)(size_t)(lds + A_V0 + (vbi) * A_VB + vro), pw)
    for (int j = 0; j < ntile; ++j) {
        const int b = j & 1;
        ATT_WRITE(b, vb3);
        __syncthreads();
        if (j + 1 < ntile) { const int jn = j + 1; const int tokn = jn < 4 ? A.ctx_tok + 64 * jn : A.lat_tok + 64 * (A.t_lo + jn - 4); ATT_LOAD(tokn); }
        if (grp == 1 && have_prev) { const int vp = vb3 == 0 ? 2 : vb3 - 1; ATT_PV(vp); have_prev = false; }
        const int t = A.t_lo + j - 4;
        if (!(j >= 4 && (t < A.w_lo || t >= A.w_hi))) {
        const LAS unsigned char* kb = lds + A_K0 + b * A_KB + kro;
        f32x16 st0 = negm, st1 = negm;
        { bf16x8 kfa[NS], kfc[NS]; const unsigned ka_ = (unsigned)(size_t)kb;
#pragma unroll
          for (int s = 0; s < NS; ++s) { lds_rd128(kfa[s], ka_, 32 * s); lds_rd128(kfc[s], ka_, 32 * KSTR + 32 * s); }
          lds_wait<2 * NS - 4>(kfa[0], kfc[0], kfa[1], kfc[1]);
#pragma unroll
          for (int s = 0; s < 2; ++s) { st0 = __builtin_amdgcn_mfma_f32_32x32x16_bf16(kfa[s], qf[s], st0, 0, 0, 0); st1 = __builtin_amdgcn_mfma_f32_32x32x16_bf16(kfc[s], qf[s], st1, 0, 0, 0); }
          lds_wait<2 * NS - 8>(kfa[2], kfc[2], kfa[3], kfc[3]);
#pragma unroll
          for (int s = 2; s < 4; ++s) { st0 = __builtin_amdgcn_mfma_f32_32x32x16_bf16(kfa[s], qf[s], st0, 0, 0, 0); st1 = __builtin_amdgcn_mfma_f32_32x32x16_bf16(kfc[s], qf[s], st1, 0, 0, 0); }
          if constexpr (NS == 6) { lds_wait<0>(kfa[4], kfc[4], kfa[5], kfc[5]);
#pragma unroll
              for (int s = 4; s < 6; ++s) { st0 = __builtin_amdgcn_mfma_f32_32x32x16_bf16(kfa[s], qf[s], st0, 0, 0, 0); st1 = __builtin_amdgcn_mfma_f32_32x32x16_bf16(kfc[s], qf[s], st1, 0, 0, 0); } }
          }
        if (MODE == 1 && j >= 4 && !((q0w + 31 - 64 * t <= 128) && (64 * t + 63 - q0w <= 128))) {
            const int kp0 = 64 * t + 8 * hi;
#pragma unroll
            for (int i = 0; i < 16; ++i) { const int d = A.qpos - (kp0 + (i & 7) + 16 * (i >> 3)); if (d > 128 || d < -128) st0[i] = NEGV; if (d - 32 > 128 || d - 32 < -128) st1[i] = NEGV; }
        }
        if (MODE == 2 && j >= 4) {
            const LAS float* bp = (const LAS float*)(lds + A_STASH) + (t - A.qrow + 7) * 128 + (63 + 8 * hi - A.qpos);
#pragma unroll
            for (int i = 0; i < 16; ++i) { const int kk = (i & 7) + 16 * (i >> 3); st0[i] += bp[kk] + pen0[i]; st1[i] += bp[kk + 32] + pen1[i]; }
        }
        asm volatile("s_nop 15\n\ts_nop 7" : "+v"(st0), "+v"(st1));
        float mx = max3f(st0[0], st1[0], st0[1]), mx2 = max3f(st1[1], st0[2], st1[2]);
#pragma unroll
        for (int i = 3; i < 15; i += 2) { mx = max3f(mx, st0[i], st1[i]); mx2 = max3f(mx2, st0[i + 1], st1[i + 1]); }
        mx = max3f(mx, mx2, st0[15]); mx = max3f(mx, st1[15], mx);
        mx = swap_max(mx);
        if (j == 0 || __any(mx > 8.0f)) {
            const float dl = j == 0 ? mx : fmaxf(mx, 0.f); mrun += dl;
#pragma unroll
            for (int i = 0; i < 16; ++i) { st0[i] -= dl; st1[i] -= dl; negm[i] = -mrun; }
            const float f = __builtin_amdgcn_exp2f(-dl); lrun *= f;
#pragma unroll
            for (int db = 0; db < NDB; ++db)
#pragma unroll
                for (int i = 0; i < 16; ++i) o[db][i] *= f;
        }
        float ps = 0.f;
#pragma unroll
        for (int i = 0; i < 16; ++i) { st0[i] = __builtin_amdgcn_exp2f(st0[i]); st1[i] = __builtin_amdgcn_exp2f(st1[i]); ps += st0[i] + st1[i]; }
        lrun += ps;
#pragma unroll
        for (int s = 0; s < 2; ++s) { pw[s].x = pk2(st0[8 * s], st0[8 * s + 1]); pw[s].y = pk2(st0[8 * s + 2], st0[8 * s + 3]); pw[s].z = pk2(st0[8 * s + 4], st0[8 * s + 5]); pw[s].w = pk2(st0[8 * s + 6], st0[8 * s + 7]);
            pw[2 + s].x = pk2(st1[8 * s], st1[8 * s + 1]); pw[2 + s].y = pk2(st1[8 * s + 2], st1[8 * s + 3]); pw[2 + s].z = pk2(st1[8 * s + 4], st1[8 * s + 5]); pw[2 + s].w = pk2(st1[8 * s + 6], st1[8 * s + 7]); }
        if (grp == 0) ATT_PV(vb3); else have_prev = true;
        }
        vb3 = vb3 == 2 ? 0 : vb3 + 1;
    }
    if (grp == 1 && have_prev) { const int vp = vb3 == 0 ? 2 : vb3 - 1; ATT_PV(vp); }
    __syncthreads();
#undef ATT_PV
#undef ATT_LOAD
#undef ATT_WRITE
}
template <int NDB> __device__ __forceinline__ void attn_store(const f32x16 (&o)[NDB], float sc, bf16_t* yp, int hi) {
#pragma unroll
    for (int db = 0; db < NDB; ++db)
#pragma unroll
        for (int g = 0; g < 4; ++g) { u32x2 w; w.x = pk2(o[db][4 * g] * sc, o[db][4 * g + 1] * sc); w.y = pk2(o[db][4 * g + 2] * sc, o[db][4 * g + 3] * sc); *(u32x2*)(yp + 32 * db + 8 * g + 4 * hi) = w; }
}

__device__ __forceinline__ void unit_A(PP P, int b, int hq, int qb, bool latq, int tid, int wave, LAS unsigned char* lds) {
    tid = phase_tid(wave);
    const int lane = tid & 63, r32 = lane & 31, hi = lane >> 5; unsigned char* ws = P->ws;
    const bf16_t* QK = (const bf16_t*)(ws + OFF_QK0); const bf16_t* VT = (const bf16_t*)(ws + OFF_VT0); bf16_t* Y = (bf16_t*)(ws + OFF_Y);
    const int kvh = hq >> 2; const int qp0 = qb * 256 + wave * 32; const int qtok = (latq ? b * SEQ : NLAT + b * CTXL) + qp0 + r32;
    AttnArgs A; A.q = QK + (size_t)qtok * 1792 + hq * 64 + 8 * hi; A.k0 = QK + (24 + kvh) * 64; A.ld0 = 1792; A.k1 = nullptr;
    A.vt = VT + (size_t)(kvh * 64) * T; A.ctx_tok = NLAT + b * CTXL; A.lat_tok = b * SEQ;
    A.t_lo = latq ? max(4 * qb - 2, 0) : 0; A.t_hi = latq ? min(4 * qb + 6, 32) : 0;
    A.w_lo = (max(qp0 - 128, 0)) >> 6; A.w_hi = ((min(qp0 + 31 + 128, SEQ - 1)) >> 6) + 1;
    A.qpos = qp0 + r32; A.qrow = 0; A.rpb = nullptr;
    f32x16 o[2]; o[0] = f32x16{}; o[1] = f32x16{}; float m = 0.f, l = 0.f;
    attn_run<4, 2, 1>(o, m, l, A, lds, tid, r32, hi);
    l = swap_sum(l) + __builtin_amdgcn_exp2f(P->in[16][hq] * LOG2E - m);
    attn_store<2>(o, 1.0f / l, Y + (size_t)qtok * DM + hq * 64, hi);
}
__device__ __forceinline__ void unit_B(PP P, int b, int h, int qb, bool latq, int tid, int wave, LAS unsigned char* lds, float lam) {
    tid = phase_tid(wave);
    const int lane = tid & 63, r32 = lane & 31, hi = lane >> 5; unsigned char* ws = P->ws;
    const bf16_t* QK = (const bf16_t*)(ws + OFF_QK0); const bf16_t* VT = (const bf16_t*)(ws + OFF_VT0); bf16_t* Y = (bf16_t*)(ws + OFF_Y);
    const int qtok = (latq ? b * SEQ : NLAT + b * CTXL) + qb * 256 + wave * 32 + r32;
    LAS unsigned* stash = (LAS unsigned*)(lds + A_STASH + wave * 8192);
    f32x16 o[4];
#pragma unroll 1
    for (int mp = 1; mp >= 0; --mp) {
        AttnArgs A; A.q = QK + (size_t)qtok * 1792 + (8 + 2 * h + mp) * 64 + 8 * hi; A.k0 = QK + (16 + 2 * h + mp) * 64; A.ld0 = 1792; A.k1 = nullptr;
        A.vt = VT + (size_t)(128 + h * 128) * T; A.ctx_tok = NLAT + b * CTXL; A.lat_tok = b * SEQ; A.t_lo = 0; A.t_hi = latq ? 32 : 0; A.w_lo = 0; A.w_hi = 32; A.qpos = 0; A.qrow = 0; A.rpb = nullptr;
#pragma unroll
        for (int db = 0; db < 4; ++db) o[db] = f32x16{};
        float m = 0.f, l = 0.f;
        attn_run<4, 4, 0>(o, m, l, A, lds, tid, r32, hi);
        const float inv = 1.0f / swap_sum(l);
        if (mp == 1) {
#pragma unroll
            for (int db = 0; db < 4; ++db)
#pragma unroll
                for (int i = 0; i < 8; ++i) stash[(db * 8 + i) * 64 + lane] = pk2(o[db][2 * i] * inv, o[db][2 * i + 1] * inv);
        } else {
            float ss = 0.f;
#pragma unroll
            for (int db = 0; db < 4; ++db)
#pragma unroll
                for (int i = 0; i < 8; ++i) { const unsigned w = stash[(db * 8 + i) * 64 + lane];
                    const float v0 = o[db][2 * i] * inv - lam * __uint_as_float(w << 16), v1 = o[db][2 * i + 1] * inv - lam * __uint_as_float(w & 0xffff0000u);
                    o[db][2 * i] = v0; o[db][2 * i + 1] = v1; ss += v0 * v0 + v1 * v1; }
            ss = swap_sum(ss);
            const float rstd = __builtin_amdgcn_rsqf(ss * (1.0f / 128.0f) + EPS) * 0.8f;
            const int t2 = phase_tid(wave), hi2 = (t2 >> 5) & 1; const int qt2 = (latq ? b * SEQ : NLAT + b * CTXL) + qb * 256 + wave * 32 + (t2 & 31);
            const float* gn = P->in[23]; bf16_t* yp = Y + (size_t)qt2 * DM + 512 + h * 128;
#pragma unroll
            for (int db = 0; db < 4; ++db)
#pragma unroll
                for (int g = 0; g < 4; ++g) { const int d0 = 32 * db + 8 * g + 4 * hi2; const f32x4 gg = *(const f32x4*)(gn + d0);
                    u32x2 w; w.x = pk2(o[db][4 * g] * rstd * gg[0], o[db][4 * g + 1] * rstd * gg[1]); w.y = pk2(o[db][4 * g + 2] * rstd * gg[2], o[db][4 * g + 3] * rstd * gg[3]); *(u32x2*)(yp + d0) = w; }
        }
    }
}
__device__ __forceinline__ void unit_C(PP P, int b, int h, int qb, int tid, int wave, LAS unsigned char* lds) {
    tid = phase_tid(wave);
    const int lane = tid & 63, r32 = lane & 31, hi = lane >> 5; unsigned char* ws = P->ws;
    const int qtok = b * SEQ + qb * 256 + wave * 32 + r32;
    AttnArgs A; A.q = (const bf16_t*)(ws + OFF_QC) + (size_t)qtok * 768 + h * 96 + 8 * hi; A.k0 = (const bf16_t*)(ws + OFF_KC) + h * 64; A.ld0 = 512;
    A.k1 = (const bf16_t*)(ws + OFF_KR); A.vt = (const bf16_t*)(ws + OFF_CVT) + (size_t)(h * 64) * T;
    A.ctx_tok = NLAT + b * CTXL; A.lat_tok = b * SEQ; A.t_lo = 0; A.t_hi = 32; A.w_lo = 0; A.w_hi = 32; A.qpos = 0; A.qrow = 0; A.rpb = nullptr;
    f32x16 o[2]; o[0] = f32x16{}; o[1] = f32x16{}; float m = 0.f, l = 0.f;
    attn_run<6, 2, 0>(o, m, l, A, lds, tid, r32, hi);
    attn_store<2>(o, 1.0f / swap_sum(l), (bf16_t*)(ws + OFF_Y) + (size_t)qtok * DM + h * 64, hi);
}
__device__ __forceinline__ void unit_D(PP P, int b, int h, int qb, int tid, int wave, LAS unsigned char* lds) {
    tid = phase_tid(wave);
    const int lane = tid & 63, r32 = lane & 31, hi = lane >> 5; unsigned char* ws = P->ws;
    const int qtok = b * SEQ + qb * 256 + wave * 32 + r32; const bf16_t* QK = (const bf16_t*)(ws + OFF_QK1);
    const int qrow = 4 * qb + (wave >> 1), rs = min(max(qrow - 4, 0), 24);
    AttnArgs A; A.q = QK + (size_t)qtok * 1024 + h * 64 + 8 * hi; A.k0 = QK + 512 + h * 64; A.ld0 = 1024; A.k1 = nullptr;
    A.vt = (const bf16_t*)(ws + OFF_DVT) + (size_t)(h * 64) * T; A.ctx_tok = NLAT + b * CTXL; A.lat_tok = b * SEQ;
    A.t_lo = min(max(4 * qb - 4, 0), 24); A.t_hi = min(max(4 * qb + 3 - 4, 0), 24) + 8; A.w_lo = rs; A.w_hi = rs + 8;
    A.qpos = (wave & 1) * 32 + r32; A.qrow = qrow; A.rpb = nullptr;
    { const float* rp = P->in[36] + h * 15 * 31; LAS float* tb = (LAS float*)(lds + A_STASH);
      for (int i = tid; i < 15 * 128; i += 512) tb[i] = rp[(i >> 7) * 31 + min(max((i & 127) - 48, 0), 30)] * LOG2E; }
    f32x16 o[2]; o[0] = f32x16{}; o[1] = f32x16{}; float m = 0.f, l = 0.f;
    attn_run<4, 2, 2>(o, m, l, A, lds, tid, r32, hi);
    attn_store<2>(o, 1.0f / swap_sum(l), (bf16_t*)(ws + OFF_Y) + (size_t)qtok * DM + 512 + h * 64, hi);
}
__device__ __forceinline__ void attn_phase(PP P, int layer, LAS unsigned char* lds, int wave_s) {
    const int tid = phase_tid(wave_s), lane = tid & 63, wave = wave_s;
    const int G = gridDim.x; const int bx = (G % 8 == 0) ? ((int)blockIdx.x % 8) * (G / 8) + (int)blockIdx.x / 8 : (int)blockIdx.x;
    if (layer == 0) {
        const float d1 = wave_sum(P->in[19][lane] * P->in[20][lane], lane), d2 = wave_sum(P->in[21][lane] * P->in[22][lane], lane);
        const float lam = __expf(d1) - __expf(d2) + 0.2f;
#ifndef NO_UB
        for (int u = bx; u < 512; u += G) unit_B(P, u >> 5, (u >> 3) & 3, u & 7, true, tid, wave, lds, lam);
#endif
#ifndef NO_UA
        for (int u = bx; u < 1024; u += G) unit_A(P, u >> 6, (u >> 3) & 7, u & 7, true, tid, wave, lds);
#endif
#ifndef NO_UB
        for (int u = bx; u < 64; u += G) unit_B(P, u >> 2, u & 3, 0, false, tid, wave, lds, lam);
#endif
#ifndef NO_UA
        for (int u = bx - 64; u < 128; u += G) if (u >= 0) unit_A(P, u >> 3, u & 7, 0, false, tid, wave, lds);
#endif
    } else {
#ifndef NO_UC
        for (int u = bx; u < 1024; u += G) unit_C(P, u >> 6, (u >> 3) & 7, u & 7, tid, wave, lds);
#endif
#ifndef NO_UD
        for (int u = bx; u < 1024; u += G) unit_D(P, u >> 6, (u >> 3) & 7, u & 7, tid, wave, lds);
#endif
    }
}

#define XB_TMO      128
#define XB_XCNT(j)  (256  + 64 * (j))
#define XB_XSUB(j)  (1280 + 64 * (j))
#define XB_XGEN(j)  (2304 + 64 * (j))
#define XB_TOP      3328
#define XB_TOPGEN   3392
#define XCD_BAR_WORDS 3456
#define XB_SPIN_CAP (1u << 18)

__device__ __forceinline__ unsigned xb_ld(unsigned* p)              { return __hip_atomic_load(p, __ATOMIC_RELAXED, __HIP_MEMORY_SCOPE_AGENT); }
__device__ __forceinline__ unsigned xb_add(unsigned* p, unsigned v) { return __hip_atomic_fetch_add(p, v, __ATOMIC_RELAXED, __HIP_MEMORY_SCOPE_AGENT); }
__device__ __forceinline__ unsigned xb_xcc_id() { return (unsigned)__builtin_amdgcn_s_getreg((3 << 11) | 20) & 0xFu; }
#define XB_SPIN(cond, bar) do { unsigned _sp = 0; while (cond) { __builtin_amdgcn_s_sleep(1); \
    if ((++_sp & 255u) == 0u) { if (xb_ld(&(bar)[XB_TMO])) break; if (_sp > XB_SPIN_CAP) { atomicAdd(&(bar)[XB_TMO], 1u); break; } } } } while (0)

struct XcdBarrier {
    unsigned* bar; unsigned x;
    volatile LAS unsigned* st;
    int w;
};
__device__ __forceinline__ bool xb_t0(int w) { unsigned z_; asm volatile("s_mov_b32 %0, 0" : "=s"(z_)); return w == 0 && __builtin_amdgcn_mbcnt_hi(~0u, __builtin_amdgcn_mbcnt_lo(~0u, z_)) == 0u; }

__device__ __forceinline__ XcdBarrier xcd_barrier_post(unsigned* bar, volatile LAS unsigned* st, int w) {
    XcdBarrier b; b.bar = bar; b.x = xb_xcc_id(); b.st = st; b.w = w;
    if (xb_t0(w)) (void)xb_add(&bar[XB_XCNT(b.x)], 1u);
    return b;
}
__device__ __forceinline__ void xcd_barrier_complete(unsigned* bar, unsigned x, unsigned& nloc, unsigned& nx) {
    const unsigned G = gridDim.x * gridDim.y * gridDim.z;
    unsigned sum, cnt, mine, sp = 0u;
    for (;;) {
        sum = 0u; cnt = 0u; mine = 0u;
#pragma unroll
        for (unsigned j = 0; j < 16; ++j) { const unsigned c = xb_ld(&bar[XB_XCNT(j)]); sum += c; cnt += (c > 0u) ? 1u : 0u; mine = (j == x) ? c : mine; }
        if (sum == G) break;
        __builtin_amdgcn_s_sleep(1);
        if ((++sp & 255u) == 0u) { if (xb_ld(&bar[XB_TMO])) break; if (sp > XB_SPIN_CAP) { atomicAdd(&bar[XB_TMO], 1u); break; } }
    }
    nloc = mine > 0u ? mine : 1u; nx = cnt > 0u ? cnt : 1u;
}

__device__ __forceinline__ void xcd_barrier(const XcdBarrier& b) {
    asm volatile("s_waitcnt vmcnt(0)" ::: "memory");
    __syncthreads();
    if (xb_t0(b.w)) {
        unsigned* bar = b.bar;
        __builtin_amdgcn_s_waitcnt(0);
        unsigned nloc = b.st[0], nx = b.st[1];
        if (nloc == 0u) { xcd_barrier_complete(bar, b.x, nloc, nx); b.st[0] = nloc; b.st[1] = nx; }
        const unsigned old = xb_add(&bar[XB_XSUB(b.x)], 1u);
        const unsigned gen = old / nloc;
        if (old + 1u == (gen + 1u) * nloc) {
            __builtin_amdgcn_fence(__ATOMIC_RELEASE, "agent");
            asm volatile("s_waitcnt vmcnt(0)" ::: "memory");
            const unsigned og = xb_add(&bar[XB_TOP], 1u);
            const unsigned tg = og / nx;
            if (og + 1u == (tg + 1u) * nx) xb_add(&bar[XB_TOPGEN], 1u);
            else XB_SPIN(xb_ld(&bar[XB_TOPGEN]) == tg, bar);
            __builtin_amdgcn_fence(__ATOMIC_ACQUIRE, "agent");
            xb_add(&bar[XB_XGEN(b.x)], 1u);
            asm volatile("s_waitcnt vmcnt(0)" ::: "memory");
        } else {
            XB_SPIN(xb_ld(&bar[XB_XGEN(b.x)]) == gen, bar);
            __builtin_amdgcn_fence(__ATOMIC_ACQUIRE, "agent");
            asm volatile("s_waitcnt vmcnt(0)" ::: "memory");
        }
    }
    __syncthreads();
}

__global__ void __launch_bounds__(NWAVES * 64, 2) fwd_megakernel(Params Parg) {
    PP P = (PP)__builtin_amdgcn_kernarg_segment_ptr();
    extern __shared__ __attribute__((aligned(16))) unsigned char lds_raw[];
    LAS unsigned char* lds = (LAS unsigned char*)lds_raw;
    cg::grid_group grid = cg::this_grid();
    const int wave_s = __builtin_amdgcn_readfirstlane(threadIdx.x >> 6);
    { volatile LAS unsigned* mz = (volatile LAS unsigned*)(lds + LDSCTL_OFF); if (wave_s == 0) mz[phase_tid(0)] = 0u; }
    __syncthreads();
    XcdBarrier bar = xcd_barrier_post((unsigned*)(((PP)__builtin_amdgcn_kernarg_segment_ptr())->ws + OFF_CTL), (volatile LAS unsigned*)(lds + LDSCTL_OFF) + 8, wave_s);

#ifndef NO_PRO
    prologue(P, lds, wave_s);
#endif
#ifdef PROBE_PRO2
    __syncthreads(); prologue(P, lds, wave_s);
#endif
    grid.sync();
    prep_phase(P, lds, wave_s);
    xcd_barrier(bar);
#pragma unroll 1
    for (int st = 0; st < 6; ++st) {
        asm volatile("" : "+s"(P));
        unsigned char* ws = P->ws;
        const float* BIAS = (const float*)(ws + OFF_BIAS); float* RS = (float*)(ws + OFF_RS);
        bf16_t* H = (bf16_t*)(ws + OFF_H); bf16_t* Y = (bf16_t*)(ws + OFF_Y); bf16_t* ACT = (bf16_t*)(ws + OFF_ACT);
        float* XL = P->out;
        const float* rope64 = (const float*)(ws + OFF_ROPE64); const float* rope32 = (const float*)(ws + OFF_ROPE32);
        const int l = st / 3, ph = st % 3; const int G = (int)gridDim.x, bx = (int)blockIdx.x;
        const bool tail = st >= 1 && st <= 4;
        const int nsub = tail ? min(64, G >> 1) : 0;
        const int P0 = tail ? (st == 1 ? 82 : st == 2 ? 8 : st == 3 ? 17 : 64) : 0;
        const int npan = (st == 5) ? NLAT / 256 : T / 256;
#pragma unroll 1
        for (int part = 0; part < 2; ++part) {
            if (part == 0 && !tail) continue;
            if (part == 0 && bx < nsub) {
                const int sp = st - 1, lp = sp / 3, pp = sp % 3;
                if (pp != 1) { const int f = pp >> 1, a = f ? 6 : 0;
                    run_gemm(lds, wave_s, ACT, (const bf16_t*)(ws + OFF_WD + (size_t)(lp * 2 + f) * SZ_WD), NCTX, DM, FF, EpiResid{XL, XL, ws, lp, a + 2, f == 0 ? lp : 1, f == 0 ? 4 : (lp == 0 ? 1 : -1), 0.5f}, 0, NLAT / 256, nsub, bx);
                } else {
                    run_gemm(lds, wave_s, Y, (const bf16_t*)(ws + (lp == 0 ? OFF_WOUT0 : OFF_WOUT1)), NCTX, DM, DM, EpiResid{XL, XL, ws, lp, 5, lp, 7, 1.0f}, 0, NLAT / 256, nsub, bx);
                }
            }
            if (part == 1 || bx >= nsub) {
                const int pb = part == 0 ? 0 : P0, pe = part == 0 ? P0 : npan, Gs = part == 0 ? G - nsub : 0, cs = part == 0 ? bx - nsub : -1;
                if (pe > pb) {
                    if (ph != 1) { const int f = ph >> 1;
                        run_gemm(lds, wave_s, H, (const bf16_t*)(ws + OFF_WGU + (size_t)(l * 2 + f) * SZ_WGU), (pe - pb) * 256, 5632, DM, EpiSwiGLU{ACT, RS, BIAS + BIAS_FFN + (l * 2 + f) * 17 * 5632}, 0, pb, Gs, cs);
                    } else if (l == 0) {
                        run_gemm(lds, wave_s, H, (const bf16_t*)(ws + OFF_WQK0), (pe - pb) * 256, 1792, DM, EpiHeads0{(bf16_t*)(ws + OFF_QK0), (const float*)(ws + OFF_GAIN), rope64, RS, BIAS + BIAS_QK0}, 0, pb, Gs, cs);
                    } else {
                        run_gemm(lds, wave_s, H, (const bf16_t*)(ws + OFF_WIN1), (pe - pb) * 256, 2304, DM,
                                 EpiHeads1{(bf16_t*)(ws + OFF_QK1), (bf16_t*)(ws + OFF_CQ), (bf16_t*)(ws + OFF_CKV), (bf16_t*)(ws + OFF_KR), (float*)(ws + OFF_PQ), (float*)(ws + OFF_PKV), P->in[34], P->in[35], P->in[33], rope32, RS, BIAS + BIAS_IN1}, 0, pb, Gs, cs);
                    }
                }
            }
            if (part == 0) xcd_barrier(bar);
        }
        if (ph != 1) {
            const int f = ph >> 1, a = f ? 6 : 0; const bool last = (st == 5);
            xcd_barrier(bar);
            run_gemm(lds, wave_s, ACT, (const bf16_t*)(ws + OFF_WD + (size_t)(l * 2 + f) * SZ_WD), NLAT, DM, FF,
                     EpiResid{st == 0 ? P->in[0] : XL, XL, ws, l, a + 2, f == 0 ? l : 1, f == 0 ? 4 : (l == 0 ? 1 : -1), 0.5f});
            if (!last) xcd_barrier(bar);
        } else {
            run_gemm(lds, wave_s, (const bf16_t*)(ws + (l == 0 ? OFF_WV0 : OFF_WDV)), H, l == 0 ? 768 : 512, T, DM,
                     EpiPlain{(bf16_t*)(ws + (l == 0 ? OFF_VT0 : OFF_DVT)), T, nullptr, RS, BIAS + (l == 0 ? BIAS_V0 : BIAS_DV), l == 0 ? 768 : 512}, 128);
            xcd_barrier(bar);
            if (l == 1) {
                run_gemm(lds, wave_s, (const bf16_t*)(ws + OFF_CQ), (const bf16_t*)(ws + OFF_WUQ), NLAT, 768, 768, EpiUq{(bf16_t*)(ws + OFF_QC), (const float*)(ws + OFF_PQ), P->in[30], P->in[31], rope32});
                run_gemm(lds, wave_s, (const bf16_t*)(ws + OFF_CKV), (const bf16_t*)(ws + OFF_WUK), T, 512, 256, EpiUk{(bf16_t*)(ws + OFF_KC), (const float*)(ws + OFF_PKV), P->in[32]}, 128);
                run_gemm(lds, wave_s, (const bf16_t*)(ws + OFF_WUV), (const bf16_t*)(ws + OFF_CKV), 512, T, 256, EpiPlain{(bf16_t*)(ws + OFF_CVT), T, (const float*)(ws + OFF_PKV), nullptr, nullptr, 0}, 96);
                xcd_barrier(bar);
            }
            attn_phase(P, l, lds, wave_s);
            xcd_barrier(bar);
            run_gemm(lds, wave_s, Y, (const bf16_t*)(ws + (l == 0 ? OFF_WOUT0 : OFF_WOUT1)), NLAT, DM, DM, EpiResid{XL, XL, ws, l, 5, l, 7, 1.0f});
            xcd_barrier(bar);
        }
    }
}

extern "C" void kernel_launch(void* const* d_in, const int* in_sizes, int n_in, void* d_out, int out_size, void* d_ws, size_t ws_size, hipStream_t stream) {
    static int grid = 0;
    if (grid == 0) {
        if (n_in != 37 || ws_size < WS_END) { fprintf(stderr, "kernel_launch: unexpected n_in %d / ws %zu\n", n_in, ws_size); grid = -1; return; }
        int dev = 0, cus = 0, per_cu = 0;
        hipGetDevice(&dev); hipDeviceGetAttribute(&cus, hipDeviceAttributeMultiprocessorCount, dev);
        hipFuncSetAttribute((const void*)fwd_megakernel, hipFuncAttributeMaxDynamicSharedMemorySize, LDS_BYTES);
        hipOccupancyMaxActiveBlocksPerMultiprocessor(&per_cu, (const void*)fwd_megakernel, NWAVES * 64, LDS_BYTES);
        if (per_cu < 1) { fprintf(stderr, "kernel_launch: occupancy query says %d blocks per CU\n", per_cu); per_cu = 1; }
        (void)hipGetLastError();
        grid = cus;
    }
    if (grid < 0) return;
    if (hipMemsetAsync((char*)d_ws + OFF_CTL, 0, 16384, stream) != hipSuccess) { fprintf(stderr, "kernel_launch: memset failed\n"); return; }
    Params p{};
    for (int i = 0; i < 37; ++i) p.in[i] = (const float*)d_in[i];
    p.out = (float*)d_out; p.ws = (unsigned char*)d_ws;
    void* args[] = {&p};
    hipError_t e = hipLaunchCooperativeKernel((const void*)fwd_megakernel, dim3(grid), dim3(NWAVES * 64), args, LDS_BYTES, stream);
    if (e != hipSuccess) fprintf(stderr, "cooperative launch failed: %s (grid %d)\n", hipGetErrorString(e), grid);
}
```

```cpp
#include <hip/hip_runtime.h>
#include <hip/hip_cooperative_groups.h>
#include <cstdio>
#include <cstdint>
namespace cg = cooperative_groups;
namespace pg8 {
#define PG8_LAS __attribute__((address_space(3)))
typedef unsigned short bf16_t;
typedef short bf16x8 __attribute__((ext_vector_type(8)));
typedef float f32x4 __attribute__((ext_vector_type(4)));
typedef unsigned u32x4 __attribute__((ext_vector_type(4)));
constexpr int BM = 256, BK = 64, HALF = 128, HTB = HALF * BK * 2  , STAGE_BYTES = 8 * HTB, NXCD = 8, WGM = 8;

__host__ __device__ __forceinline__ int lds_byte(int r, int c) { const int st = (r >> 4) * 2 + (c >> 5), rr = r & 15, cc = c & 31, ob = rr * 64 + cc * 2; return st * 1024 + (ob ^ (((ob >> 9) & 1) << 5)); }
__host__ __device__ __forceinline__ void stage_rc(int b, int& R, int& C) { const int st = b / 1024, sb = b % 1024, swz = sb ^ (((sb >> 9) & 1) << 5); R = (st >> 1) * 16 + swz / 64; C = (st & 1) * 32 + (swz % 64) / 2; }
__host__ __device__ __forceinline__ int perm32(int rho) { const int n = rho >> 4, i = rho & 15; return 8 * (i >> 2) + 4 * n + (i & 3); }

struct Unit { int pm, pn; };
struct Gemm { const bf16_t* A; const bf16_t* Bt; int M, N, K, ld; };

struct StaticOrder {
    int nM, nN, nwg, G, c;
    __host__ __device__ void init(int M, int N, int G_, int c_) { nM = M / BM; nN = N / BM; nwg = nM * nN; G = G_; c = c_; }
    __host__ __device__ bool next(int i, Unit& u) const {
        const long L = (long)i * G + c; if (L >= nwg) return false;
        int wgid = (int)L; { const int q = nwg / NXCD, r = nwg % NXCD, xcd = wgid % NXCD, off = wgid / NXCD; wgid = (xcd < r ? xcd * (q + 1) : r * (q + 1) + (xcd - r) * q) + off; }
        const int nig = WGM * nN, gid = wgid / nig, fm = gid * WGM, gsz = (nM - fm) < WGM ? (nM - fm) : WGM;
        u.pm = fm + ((wgid % nig) % gsz); u.pn = (wgid % nig) / gsz; return true;
    }
    __device__ __forceinline__ void a_ready(const Unit&) const {}
    __device__ __forceinline__ void done(const Unit&) const {}
};

__device__ __forceinline__ unsigned cvt_pk_bf16(float lo, float hi) { unsigned r; asm volatile("v_cvt_pk_bf16_f32 %0, %1, %2" : "=v"(r) : "v"(lo), "v"(hi)); return r; }
template <class Epi, class Sched, bool ALIGN_EPI = false, bool SP2 = false>
__device__ __forceinline__ void gemm_phase(PG8_LAS unsigned char* lds, const Gemm g, const Sched& S, const Epi& E, int wave_s) {
    int tid_; { unsigned z_; asm volatile("s_mov_b32 %0, 0" : "=s"(z_)); tid_ = (wave_s << 6) | (int)__builtin_amdgcn_mbcnt_hi(~0u, __builtin_amdgcn_mbcnt_lo(~0u, z_)); }
    const int tid = tid_, wid = __builtin_amdgcn_readfirstlane(tid >> 6), lane = tid & 63, wr = wid >> 2, wc = wid & 3, fr = lane & 15, fq = lane >> 4;
    const int K = g.ld, nt = g.K / BK;
    unsigned voffA[2], voffB[2];
#pragma unroll
    for (int i = 0; i < 2; ++i) { int R, C; stage_rc(tid * 16 + i * 8192, R, C); const int Rb = Epi::PERM ? ((R & ~31) + perm32(R & 31)) : R;
        voffA[i] = (unsigned)(R * K + C) * 2u; voffB[i] = (unsigned)(Rb * K + C) * 2u; }
    const size_t kstep = (size_t)(BK * 2);
    const size_t hstep = (size_t)HALF * K * 2;
    const size_t tstep = 2 * hstep;
    const unsigned ldsw = (unsigned)wid * 1024u;
    const int aoff = lds_byte(wr * 64 + fr, fq * 8), boff = lds_byte(wc * 32 + fr, fq * 8);
#define PG8_SA(b, h) (((b) * 2 + (h)) * HTB)
#define PG8_SB(b, h) ((4 + (b) * 2 + (h)) * HTB)
#define PG8_STAGE(bufoff, gbase, voff) do { _Pragma("unroll") for (int _i = 0; _i < 2; ++_i) \
        __builtin_amdgcn_global_load_lds((const unsigned*)((const char*)(gbase) + (voff)[_i]), (PG8_LAS unsigned*)(lds + (bufoff) + ldsw + _i * 8192), 16, 0, 0); } while (0)
#define PG8_LDA(dst, b, h) do { _Pragma("unroll") for (int m = 0; m < 4; ++m) _Pragma("unroll") for (int k = 0; k < 2; ++k) dst[m][k] = *(const PG8_LAS bf16x8*)(lds + PG8_SA(b, h) + aoff + m * 2048 + k * 1024); } while (0)
#define PG8_LDB(dst, b, h) do { _Pragma("unroll") for (int n = 0; n < 2; ++n) _Pragma("unroll") for (int k = 0; k < 2; ++k) dst[n][k] = *(const PG8_LAS bf16x8*)(lds + PG8_SB(b, h) + boff + n * 2048 + k * 1024); } while (0)
#define PG8_MMA(ai, bj, At, Bt) do { __builtin_amdgcn_s_setprio(1); _Pragma("unroll") for (int m = 0; m < 4; ++m) _Pragma("unroll") for (int n = 0; n < 2; ++n) _Pragma("unroll") for (int k = 0; k < 2; ++k) \
        acc[ai][bj][m][n] = __builtin_amdgcn_mfma_f32_16x16x32_bf16(Bt[n][k], At[m][k], acc[ai][bj][m][n], 0, 0, 0); __builtin_amdgcn_s_setprio(0); } while (0)
#define PG8_WAIT_V(n) asm volatile("s_waitcnt vmcnt(" #n ")" ::: "memory")
#define PG8_WAIT_L(n) asm volatile("s_waitcnt lgkmcnt(" #n ")" ::: "memory")
#define PG8_BAR __builtin_amdgcn_s_barrier()
#define PG8_SCHED __builtin_amdgcn_sched_barrier(0)
    Unit cur, nxt; int ui = 0;
    if (!S.next(0, cur)) return;
    f32x4 acc[2][2][4][2];
#pragma unroll
    for (int a = 0; a < 2; ++a)
#pragma unroll
        for (int b = 0; b < 2; ++b)
#pragma unroll
            for (int m = 0; m < 4; ++m)
#pragma unroll
                for (int n = 0; n < 2; ++n) acc[a][b][m][n] = (f32x4){0.f, 0.f, 0.f, 0.f};
    bf16x8 At[4][2], B0[2][2], B1[2][2];
    const char* cA = (const char*)g.A + (size_t)cur.pm * tstep; const char* cB = (const char*)g.Bt + (size_t)cur.pn * tstep;
    S.a_ready(cur);
    if constexpr (SP2) {
        PG8_STAGE(PG8_SB(0, 0), cB, voffB); PG8_STAGE(PG8_SB(0, 1), cB + hstep, voffB); PG8_STAGE(PG8_SA(0, 0), cA, voffA); PG8_STAGE(PG8_SA(0, 1), cA + hstep, voffA);
        if (wr == 1) PG8_BAR;
        PG8_WAIT_V(2); PG8_BAR;
        PG8_STAGE(PG8_SB(1, 0), cB + kstep, voffB); PG8_STAGE(PG8_SA(1, 0), cA + kstep, voffA); PG8_STAGE(PG8_SB(1, 1), cB + hstep + kstep, voffB);
        PG8_WAIT_V(6); PG8_BAR;
    } else {
        PG8_STAGE(PG8_SB(0, 0), cB, voffB); PG8_STAGE(PG8_SA(0, 0), cA, voffA); PG8_STAGE(PG8_SB(0, 1), cB + hstep, voffB); PG8_STAGE(PG8_SA(0, 1), cA + hstep, voffA);
        if (wr == 1) PG8_BAR;
        PG8_WAIT_V(4); PG8_BAR;
        PG8_STAGE(PG8_SB(1, 0), cB + kstep, voffB); PG8_STAGE(PG8_SA(1, 0), cA + kstep, voffA); PG8_STAGE(PG8_SB(1, 1), cB + hstep + kstep, voffB);
        PG8_WAIT_V(6); PG8_BAR;
    }
    for (;;) {
        const bool has_next = S.next(ui + 1, nxt);
        const char* nA = has_next ? (const char*)g.A + (size_t)nxt.pm * tstep : cA; const char* nB = has_next ? (const char*)g.Bt + (size_t)nxt.pn * tstep : cB;
        for (int t = 0; t < nt; t += 2) {
            const bool last = (t == nt - 2);
            const char* a1 = cA + (size_t)(t + 1) * kstep;
            const char* a2 = last ? nA : cA + (size_t)(t + 2) * kstep; const char* b2 = last ? nB : cB + (size_t)(t + 2) * kstep;
            const char* a3 = a2 + kstep; const char* b3 = b2 + kstep;
            if (last && has_next) S.a_ready(nxt);
            if constexpr (SP2) {
            PG8_LDB(B0, 0, 0); PG8_LDB(B1, 0, 1); PG8_SCHED; PG8_LDA(At, 0, 0); PG8_STAGE(PG8_SA(1, 1), a1 + hstep, voffA);
            PG8_WAIT_V(8); PG8_WAIT_L(0); PG8_BAR; PG8_MMA(0, 0, At, B0); PG8_MMA(0, 1, At, B1); PG8_BAR; PG8_SCHED;
            PG8_LDA(At, 0, 1); PG8_STAGE(PG8_SB(0, 0), b2, voffB); PG8_STAGE(PG8_SB(0, 1), b2 + hstep, voffB); PG8_STAGE(PG8_SA(0, 0), a2, voffA);
            PG8_WAIT_V(8); PG8_WAIT_L(0); PG8_BAR; PG8_MMA(1, 0, At, B0); PG8_MMA(1, 1, At, B1); PG8_BAR; PG8_SCHED;
            PG8_LDB(B0, 1, 0); PG8_LDB(B1, 1, 1); PG8_SCHED; PG8_LDA(At, 1, 0); PG8_STAGE(PG8_SA(0, 1), a2 + hstep, voffA);
            PG8_WAIT_V(8); PG8_WAIT_L(0); PG8_BAR; PG8_MMA(0, 0, At, B0); PG8_MMA(0, 1, At, B1); PG8_BAR; PG8_SCHED;
            PG8_LDA(At, 1, 1); PG8_STAGE(PG8_SB(1, 0), b3, voffB); PG8_STAGE(PG8_SB(1, 1), b3 + hstep, voffB); PG8_STAGE(PG8_SA(1, 0), a3, voffA);
            PG8_WAIT_V(8); PG8_WAIT_L(0); PG8_BAR; PG8_MMA(1, 0, At, B0); PG8_MMA(1, 1, At, B1); PG8_BAR; PG8_SCHED;
            } else {
            PG8_LDB(B0, 0, 0); PG8_SCHED; PG8_LDA(At, 0, 0); PG8_STAGE(PG8_SA(1, 1), a1 + hstep, voffA);
            PG8_WAIT_L(8); PG8_BAR; PG8_WAIT_L(0); PG8_MMA(0, 0, At, B0); PG8_BAR; PG8_SCHED;
            PG8_LDB(B1, 0, 1); PG8_STAGE(PG8_SB(0, 0), b2, voffB);
            PG8_BAR; PG8_WAIT_L(0); PG8_MMA(0, 1, At, B1); PG8_BAR;
            PG8_LDA(At, 0, 1); PG8_STAGE(PG8_SA(0, 0), a2, voffA);
            PG8_BAR; PG8_WAIT_L(0); PG8_MMA(1, 0, At, B0); PG8_BAR; PG8_SCHED;
            PG8_STAGE(PG8_SB(0, 1), b2 + hstep, voffB);
            PG8_WAIT_V(6); PG8_BAR; PG8_MMA(1, 1, At, B1); PG8_BAR;
            PG8_LDB(B0, 1, 0); PG8_SCHED; PG8_LDA(At, 1, 0); PG8_STAGE(PG8_SA(0, 1), a2 + hstep, voffA);
            PG8_WAIT_L(8); PG8_BAR; PG8_WAIT_L(0); PG8_MMA(0, 0, At, B0); PG8_BAR; PG8_SCHED;
            PG8_LDB(B1, 1, 1); PG8_STAGE(PG8_SB(1, 0), b3, voffB);
            PG8_BAR; PG8_WAIT_L(0); PG8_MMA(0, 1, At, B1); PG8_BAR;
            PG8_LDA(At, 1, 1); PG8_STAGE(PG8_SA(1, 0), a3, voffA);
            PG8_BAR; PG8_WAIT_L(0); PG8_MMA(1, 0, At, B0); PG8_BAR; PG8_SCHED;
            PG8_STAGE(PG8_SB(1, 1), b3 + hstep, voffB);
            PG8_WAIT_V(6); PG8_BAR; PG8_MMA(1, 1, At, B1); PG8_BAR;
            }
        }
        if constexpr (ALIGN_EPI) { if (wr == 0) PG8_BAR; }
        if constexpr (!Epi::AFTER_DRAIN) { E(acc, cur, wr, wc, fr, fq); S.done(cur); }
        if (!has_next) break;
#pragma unroll
        for (int a = 0; a < 2; ++a)
#pragma unroll
            for (int b = 0; b < 2; ++b)
#pragma unroll
                for (int m = 0; m < 4; ++m)
#pragma unroll
                    for (int n = 0; n < 2; ++n) acc[a][b][m][n] = (f32x4){0.f, 0.f, 0.f, 0.f};
        cur = nxt; cA = nA; cB = nB; ++ui;
        if constexpr (ALIGN_EPI) { if (wr == 1) PG8_BAR; }
    }
    PG8_WAIT_V(0);
    if constexpr (!ALIGN_EPI) { if (wr == 0) PG8_BAR; }
    PG8_BAR;
    if constexpr (Epi::AFTER_DRAIN) { E.fused(acc, cur, wr, wc, fr, fq, lds, wid, lane); S.done(cur); }
#undef PG8_SA
#undef PG8_SB
#undef PG8_STAGE
#undef PG8_LDA
#undef PG8_LDB
#undef PG8_MMA
#undef PG8_WAIT_V
#undef PG8_WAIT_L
#undef PG8_BAR
#undef PG8_SCHED
}
}
using pg8::bf16_t; using pg8::bf16x8; using pg8::f32x4; using pg8::u32x4; using pg8::Unit;
typedef float f32x16 __attribute__((ext_vector_type(16)));
typedef unsigned u32x2 __attribute__((ext_vector_type(2)));
#define LAS __attribute__((address_space(3)))

constexpr int NLAT = 32768, NCTX = 4096, T = NLAT + NCTX, DM = 1024, FF = 2816, SEQ = 2048, CTXL = 256;
constexpr int NMODROW = 17, MODW = 9216;
constexpr float EPS = 1e-6f, LOG2E = 1.4426950408889634f, NEGV = -1e30f;
constexpr float SC64 = 0.125f * LOG2E, SC96 = 0.10206207261596577f * LOG2E;
constexpr int NWAVES = 8;

constexpr size_t MiB = 1u << 20;
constexpr size_t SZ_WGU = (size_t)5632 * 1024 * 2, SZ_WD = (size_t)1024 * 2816 * 2;
constexpr size_t OFF_WGU = 0, OFF_WD = OFF_WGU + 4 * SZ_WGU;
constexpr size_t OFF_WQK0 = OFF_WD + 4 * SZ_WD;
constexpr size_t OFF_WV0 = OFF_WQK0 + (size_t)1792 * 1024 * 2;
constexpr size_t OFF_WOUT0 = OFF_WV0 + (size_t)768 * 1024 * 2;
constexpr size_t OFF_WIN1 = OFF_WOUT0 + (size_t)1024 * 1024 * 2;
constexpr size_t OFF_WDV = OFF_WIN1 + (size_t)2304 * 1024 * 2;
constexpr size_t OFF_WOUT1 = OFF_WDV + (size_t)512 * 1024 * 2;
constexpr size_t OFF_WUQ = OFF_WOUT1 + (size_t)1024 * 1024 * 2;
constexpr size_t OFF_WUK = OFF_WUQ + (size_t)768 * 768 * 2;
constexpr size_t OFF_WUV = OFF_WUK + (size_t)512 * 256 * 2;
constexpr size_t OFF_CTL = 82 * MiB + 512 * 1024;
constexpr size_t OFF_MOD = 83 * MiB;
constexpr size_t OFF_ROPE64 = 85 * MiB, OFF_ROPE32 = OFF_ROPE64 + 64 * 16 * 8;
constexpr size_t OFF_GAIN = OFF_ROPE32 + 64 * 8 * 8;
constexpr size_t OFF_XCTX = 86 * MiB;
constexpr size_t OFF_H = 102 * MiB;
constexpr size_t OFF_Y = 174 * MiB;
constexpr size_t OFF_ACT = 246 * MiB;
constexpr size_t OFF_EXTRA = 444 * MiB;
constexpr size_t OFF_DVT = OFF_EXTRA;
constexpr size_t OFF_PQ = OFF_EXTRA + 36 * MiB;
constexpr size_t OFF_PKV = OFF_PQ + 2 * MiB;
constexpr size_t OFF_RS = OFF_PKV + 1 * MiB;
constexpr size_t OFF_BIAS = OFF_RS + 3 * MiB;
constexpr int BIAS_FFN = 0, BIAS_QK0 = 4 * 17 * 5632, BIAS_V0 = BIAS_QK0 + 17 * 1792, BIAS_IN1 = BIAS_V0 + 17 * 768, BIAS_DV = BIAS_IN1 + 17 * 2304, BIAS_END = BIAS_DV + 17 * 512;
constexpr size_t WS_END = OFF_BIAS + 2 * MiB;
static_assert((size_t)BIAS_END * 4 <= 2 * MiB, "bias tables");
constexpr size_t OFF_QK0 = OFF_ACT, OFF_VT0 = OFF_ACT + 126 * MiB;
constexpr size_t OFF_QK1 = OFF_ACT, OFF_CQ = OFF_ACT + 72 * MiB, OFF_CKV = OFF_ACT + 126 * MiB, OFF_KR = OFF_ACT + 144 * MiB, OFF_QC = OFF_ACT + 147 * MiB;
constexpr size_t OFF_KC = OFF_H, OFF_CVT = OFF_H + 36 * MiB;
static_assert(OFF_WUV + (size_t)512 * 256 * 2 <= OFF_CTL && WS_END <= 512 * MiB && OFF_QC + (size_t)NLAT * 768 * 2 <= OFF_ACT + 198 * MiB, "ws map");

constexpr int RING_BYTES = 131072, LDSCTL_OFF = 147456, LDS_BYTES = LDSCTL_OFF + 1024;

struct Params { const float* in[37]; float* out; unsigned char* ws; };
typedef const __attribute__((address_space(4))) Params* PP;

typedef float f32x2_t __attribute__((ext_vector_type(2))); typedef __bf16 bf16x2_t __attribute__((ext_vector_type(2)));
__device__ __forceinline__ unsigned pk2(float lo, float hi) { const f32x2_t v = {lo, hi}; return __builtin_bit_cast(unsigned, __builtin_convertvector(v, bf16x2_t)); }
__device__ __forceinline__ float max3f(float a, float b, float c) { float r; asm("v_max3_f32 %0, %1, %2, %3" : "=v"(r) : "v"(a), "v"(b), "v"(c)); return r; }
__device__ __forceinline__ float swap_max(float v) { auto rr = __builtin_amdgcn_permlane32_swap(__float_as_uint(v), __float_as_uint(v), false, false); return fmaxf(__uint_as_float(rr[0]), __uint_as_float(rr[1])); }
__device__ __forceinline__ float swap_sum(float v) { auto rr = __builtin_amdgcn_permlane32_swap(__float_as_uint(v), __float_as_uint(v), false, false); return __uint_as_float(rr[0]) + __uint_as_float(rr[1]); }
__device__ __forceinline__ float swap16_sum(float v) { auto rr = __builtin_amdgcn_permlane16_swap(__float_as_uint(v), __float_as_uint(v), false, false); return __uint_as_float(rr[0]) + __uint_as_float(rr[1]); }
__device__ __forceinline__ float wave_sum(float v, int lane) {
#pragma unroll
    for (int o = 1; o < 16; o <<= 1) v += __uint_as_float(__builtin_amdgcn_ds_bpermute((lane ^ o) << 2, __float_as_uint(v)));
    return swap_sum(swap16_sum(v));
}
__device__ __forceinline__ float silu_f(float x) { return x * __builtin_amdgcn_rcpf(1.0f + __builtin_amdgcn_exp2f(-x * LOG2E)); }
__device__ __forceinline__ int headperm(int H, int d) { return 256 * (H >> 2) + ((d < 32) ? (32 * (H & 3) + d) : (128 + 32 * (H & 3) + (d - 32))); }
__device__ __forceinline__ int r32perm(int d) { const int axis = d >> 4, half = (d >> 3) & 1, f = d & 7; return 16 * half + 4 * (axis * 2 + (f >> 2)) + (f & 3); }

__device__ __forceinline__ float row_rstd(const float* RS, int r) {
    const f32x4 a = *(const f32x4*)(RS + (size_t)r * 16), b = *(const f32x4*)(RS + (size_t)r * 16 + 4), c = *(const f32x4*)(RS + (size_t)r * 16 + 8), d = *(const f32x4*)(RS + (size_t)r * 16 + 12);
    return __builtin_amdgcn_rsqf((((a.x + a.y) + (a.z + a.w)) + ((b.x + b.y) + (b.z + b.w)) + ((c.x + c.y) + (c.z + c.w)) + ((d.x + d.y) + (d.z + d.w))) * (1.0f / DM) + EPS);
}
typedef const f32x4 (&AccRef)[2][2][4][2];

__device__ __forceinline__ void rows_rstd8(const float* RS, int r0, int fq, float (&rs)[8]) {
    f32x4 p[8];
#pragma unroll
    for (int i = 0; i < 8; ++i) p[i] = *(const f32x4*)(RS + (size_t)(r0 + (i >> 2) * 128 + (i & 3) * 16) * 16 + 4 * fq);
#pragma unroll
    for (int i = 0; i < 8; ++i) { const float s = swap_sum(swap16_sum((p[i].x + p[i].y) + (p[i].z + p[i].w))); rs[i] = __builtin_amdgcn_rsqf(s * (1.0f / DM) + EPS); }
}
struct EpiPlain {
    static constexpr bool PERM = true, AFTER_DRAIN = false;
    bf16_t* O; int ldc; const float* colpart; const float* RS; const float* bias; int nb;
    __device__ __forceinline__ void operator()(AccRef acc, const Unit& u, int wr, int wc, int fr, int fq) const {
        const int row0 = u.pm * 256 + wr * 64 + fr, col0 = u.pn * 256 + wc * 32 + 8 * fq;
        float cs[2][8];
#pragma unroll
        for (int bj = 0; bj < 2; ++bj)
#pragma unroll
            for (int e = 0; e < 8; ++e) {
                if (colpart) { const f32x4 p = *(const f32x4*)(colpart + (size_t)(col0 + bj * 128 + e) * 4); cs[bj][e] = __builtin_amdgcn_rsqf(((p.x + p.y) + (p.z + p.w)) * (1.0f / 256.0f) + EPS); }
                else cs[bj][e] = 1.0f;
            }
        if (RS) {
            const float mine = row_rstd(RS, col0 + (fr >> 3) * 128 + (fr & 7));
#pragma unroll
            for (int bj = 0; bj < 2; ++bj)
#pragma unroll
                for (int e = 0; e < 8; ++e) cs[bj][e] = __uint_as_float(__builtin_amdgcn_ds_bpermute((fq * 16 + bj * 8 + e) << 2, __float_as_uint(mine)));
        }
        const int ctok = u.pn * 256; const float* bp = bias ? bias + (size_t)(ctok < NLAT ? (ctok >> 11) : 16) * nb : nullptr;
#pragma unroll
        for (int ai = 0; ai < 2; ++ai)
#pragma unroll
            for (int m = 0; m < 4; ++m) {
                const int r = row0 + ai * 128 + m * 16; const float rb = bp ? bp[r] : 0.f;
                bf16_t* rowp = O + (size_t)r * ldc + col0;
#pragma unroll
                for (int bj = 0; bj < 2; ++bj) {
                    const f32x4 v0 = acc[ai][bj][m][0], v1 = acc[ai][bj][m][1];
                    u32x4 w; w.x = pk2(v0[0] * cs[bj][0] + rb, v0[1] * cs[bj][1] + rb); w.y = pk2(v0[2] * cs[bj][2] + rb, v0[3] * cs[bj][3] + rb);
                    w.z = pk2(v1[0] * cs[bj][4] + rb, v1[1] * cs[bj][5] + rb); w.w = pk2(v1[2] * cs[bj][6] + rb, v1[3] * cs[bj][7] + rb);
                    *(u32x4*)(rowp + bj * 128) = w;
                }
            }
    }
};

struct EpiSwiGLU {
    static constexpr bool PERM = true, AFTER_DRAIN = false;
    bf16_t* ACT; const float* RS; const float* bias;
    __device__ __forceinline__ void operator()(AccRef acc, const Unit& u, int wr, int wc, int fr, int fq) const {
        const int prow = u.pm * 256; const int row0 = prow + wr * 64 + fr, col0 = u.pn * 128 + wc * 32 + 8 * fq;
        const float* bp = bias + (size_t)(prow < NLAT ? (prow >> 11) : 16) * 5632 + u.pn * 256 + wc * 32 + 8 * fq;
        const f32x4 bg0 = *(const f32x4*)(bp), bg1 = *(const f32x4*)(bp + 4), bu0 = *(const f32x4*)(bp + 128), bu1 = *(const f32x4*)(bp + 132);
        float rsv[8]; rows_rstd8(RS, row0, fq, rsv);
#pragma unroll
        for (int ai = 0; ai < 2; ++ai)
#pragma unroll
            for (int m = 0; m < 4; ++m) {
                const int r = row0 + ai * 128 + m * 16; const float rs = rsv[ai * 4 + m];
                const f32x4 g0 = acc[ai][0][m][0] * rs + bg0, g1 = acc[ai][0][m][1] * rs + bg1, u0 = acc[ai][1][m][0] * rs + bu0, u1 = acc[ai][1][m][1] * rs + bu1;
                u32x4 w;
                w.x = pk2(silu_f(g0[0]) * u0[0], silu_f(g0[1]) * u0[1]); w.y = pk2(silu_f(g0[2]) * u0[2], silu_f(g0[3]) * u0[3]);
                w.z = pk2(silu_f(g1[0]) * u1[0], silu_f(g1[1]) * u1[1]); w.w = pk2(silu_f(g1[2]) * u1[2], silu_f(g1[3]) * u1[3]);
                *(u32x4*)(ACT + (size_t)r * FF + col0) = w;
                asm volatile("" ::: "memory");
            }
    }
};

struct EpiResid {
    static constexpr bool PERM = false, AFTER_DRAIN = false;
    const float* srcL; float* dstL; unsigned char* ws; int l, which, scn_l, scn_i; float gs;
    __device__ __forceinline__ void operator()(AccRef acc, const Unit& u, int wr, int wc, int fr_in, int fq_in) const {
        int fr = fr_in, fq = fq_in; asm volatile("" : "+v"(fr), "+v"(fq));
        const float* MODp = (const float*)(ws + OFF_MOD); const float* modl = MODp + (size_t)l * NMODROW * MODW;
        const float* scn = scn_i >= 0 ? MODp + (size_t)scn_l * NMODROW * MODW + scn_i * DM : nullptr;
        bf16_t* Hn = (bf16_t*)(ws + OFF_H); float* RS = (float*)(ws + OFF_RS); float* XCp = (float*)(ws + OFF_XCTX);
        const int row0 = u.pm * 256; const bool lat = row0 < NLAT; const int bidx = lat ? (row0 >> 11) : 16;
        const float* src = lat ? srcL + (size_t)row0 * DM : XCp + (size_t)(row0 - NLAT) * DM;
        float* dst = lat ? dstL + (size_t)row0 * DM : XCp + (size_t)(row0 - NLAT) * DM;
        const int col0 = u.pn * 256 + wc * 32 + 4 * fq;
        const float* gp = modl + (size_t)bidx * MODW + which * DM + col0;
        f32x4 gv[2][2], sv[2][2];
#pragma unroll
        for (int bj = 0; bj < 2; ++bj)
#pragma unroll
            for (int n = 0; n < 2; ++n) { gv[bj][n] = *(const f32x4*)(gp + bj * 128 + n * 16) * gs; sv[bj][n] = scn ? *(const f32x4*)(scn + (size_t)bidx * MODW + col0 + bj * 128 + n * 16) + 1.0f : (f32x4){0.f, 0.f, 0.f, 0.f}; }
#pragma unroll
        for (int g = 0; g < 4; ++g) {
            const int ai = g >> 1, m0 = (g & 1) * 2;
            f32x4 xb[2][2][2];
#pragma unroll
            for (int mm = 0; mm < 2; ++mm)
#pragma unroll
                for (int bj = 0; bj < 2; ++bj)
#pragma unroll
                    for (int n = 0; n < 2; ++n) xb[mm][bj][n] = *(const f32x4*)(src + (size_t)(ai * 128 + wr * 64 + (m0 + mm) * 16 + fr) * DM + col0 + bj * 128 + n * 16);
#pragma unroll
            for (int mm = 0; mm < 2; ++mm) {
                const int m = m0 + mm; const int rr = ai * 128 + wr * 64 + m * 16 + fr; const size_t off = (size_t)rr * DM + col0; float ss = 0.f;
#pragma unroll
                for (int bj = 0; bj < 2; ++bj)
#pragma unroll
                    for (int n = 0; n < 2; ++n) { const f32x4 o = xb[mm][bj][n] + gv[bj][n] * acc[ai][bj][m][n]; *(f32x4*)(dst + off + bj * 128 + n * 16) = o;
                        if (scn) { ss += (o[0] * o[0] + o[1] * o[1]) + (o[2] * o[2] + o[3] * o[3]); const f32x4 h = o * sv[bj][n]; u32x2 w; w.x = pk2(h[0], h[1]); w.y = pk2(h[2], h[3]);
                            *(u32x2*)(Hn + (size_t)(row0 + rr) * DM + col0 + bj * 128 + n * 16) = w; } }
                if (scn) { ss = swap_sum(swap16_sum(ss)); if (fq == 0) RS[(size_t)(row0 + rr) * 16 + u.pn * 4 + wc] = ss; }
            }
            if (g == 1) asm volatile("" ::: "memory");
        }
    }
};

struct EpiResidAtomic {
    static constexpr bool PERM = false, AFTER_DRAIN = false;
    float* dstC; const float* modl; int which; float gs;
    __device__ __forceinline__ void operator()(AccRef acc, const Unit& u, int wr, int wc, int fr, int fq) const {
        float* dst = dstC + (size_t)(u.pm * 256) * DM; const int col0 = u.pn * 256 + wc * 32 + 4 * fq;
        const float* gp = modl + (size_t)16 * MODW + which * DM + col0;
        f32x4 gv[2][2];
#pragma unroll
        for (int bj = 0; bj < 2; ++bj)
#pragma unroll
            for (int n = 0; n < 2; ++n) gv[bj][n] = *(const f32x4*)(gp + bj * 128 + n * 16) * gs;
#pragma unroll
        for (int ai = 0; ai < 2; ++ai)
#pragma unroll
            for (int m = 0; m < 4; ++m) {
                float* rowp = dst + (size_t)(ai * 128 + wr * 64 + m * 16 + fr) * DM + col0;
#pragma unroll
                for (int bj = 0; bj < 2; ++bj)
#pragma unroll
                    for (int n = 0; n < 2; ++n) { const f32x4 v = gv[bj][n] * acc[ai][bj][m][n];
#pragma unroll
                        for (int e = 0; e < 4; ++e) (void)__hip_atomic_fetch_add(rowp + bj * 128 + n * 16 + e, v[e], __ATOMIC_RELAXED, __HIP_MEMORY_SCOPE_AGENT); }
            }
    }
};

__device__ __forceinline__ void head64_row(const f32x4 a00, const f32x4 a01, const f32x4 a10, const f32x4 a11, float rs, int fq, const float* gain, const float* rope64, bool do_rope, int p,
                                           float oscale, bf16_t* outp) {
    f32x4 v[2][2] = {{a00 * rs, a01 * rs}, {a10 * rs, a11 * rs}};
    float ss = 0.f;
#pragma unroll
    for (int bj = 0; bj < 2; ++bj)
#pragma unroll
        for (int n = 0; n < 2; ++n) ss += (v[bj][n][0] * v[bj][n][0] + v[bj][n][1] * v[bj][n][1]) + (v[bj][n][2] * v[bj][n][2] + v[bj][n][3] * v[bj][n][3]);
    ss = swap_sum(swap16_sum(ss));
    const float rstd = __builtin_amdgcn_rsqf(ss * (1.0f / 64.0f) + EPS);
#pragma unroll
    for (int bj = 0; bj < 2; ++bj)
#pragma unroll
        for (int n = 0; n < 2; ++n) v[bj][n] = v[bj][n] * rstd * *(const f32x4*)(gain + 32 * bj + 16 * n + 4 * fq);
    if (do_rope) {
#pragma unroll
        for (int bj = 0; bj < 2; ++bj) {
            const int pos = bj == 0 ? (p >> 6) : (p & 63);
            const f32x4 t0 = *(const f32x4*)(rope64 + (pos * 16 + 4 * fq) * 2), t1 = *(const f32x4*)(rope64 + (pos * 16 + 4 * fq) * 2 + 4);
            const f32x4 c = {t0[0], t0[2], t1[0], t1[2]}, s = {t0[1], t0[3], t1[1], t1[3]};
            const f32x4 x1 = v[bj][0], x2 = v[bj][1];
            v[bj][0] = x1 * c - x2 * s; v[bj][1] = x2 * c + x1 * s;
        }
    }
#pragma unroll
    for (int bj = 0; bj < 2; ++bj)
#pragma unroll
        for (int n = 0; n < 2; ++n) { const f32x4 o = v[bj][n] * oscale; u32x2 w; w.x = pk2(o[0], o[1]); w.y = pk2(o[2], o[3]); *(u32x2*)(outp + 32 * bj + 16 * n + 4 * fq) = w; }
}
__device__ __forceinline__ void head32_row(const f32x4 a0, const f32x4 a1, float rs, int fq, const float* gain, const float* rope32, bool do_rope, int p, float oscale, bf16_t* outp) {
    f32x4 v[2] = {a0 * rs, a1 * rs};
    float ss = (v[0][0] * v[0][0] + v[0][1] * v[0][1]) + (v[0][2] * v[0][2] + v[0][3] * v[0][3]) + (v[1][0] * v[1][0] + v[1][1] * v[1][1]) + (v[1][2] * v[1][2] + v[1][3] * v[1][3]);
    ss = swap_sum(swap16_sum(ss));
    const float rstd = __builtin_amdgcn_rsqf(ss * (1.0f / 32.0f) + EPS);
    const int axis = fq >> 1, fo = (fq & 1) * 4;
#pragma unroll
    for (int n = 0; n < 2; ++n) v[n] = v[n] * rstd * *(const f32x4*)(gain + axis * 16 + n * 8 + fo);
    if (do_rope) {
        const int pos = axis == 0 ? (p >> 6) : (p & 63);
        const f32x4 t0 = *(const f32x4*)(rope32 + (pos * 8 + fo) * 2), t1 = *(const f32x4*)(rope32 + (pos * 8 + fo) * 2 + 4);
        const f32x4 c = {t0[0], t0[2], t1[0], t1[2]}, s = {t0[1], t0[3], t1[1], t1[3]};
        const f32x4 x1 = v[0], x2 = v[1];
        v[0] = x1 * c - x2 * s; v[1] = x2 * c + x1 * s;
    }
#pragma unroll
    for (int n = 0; n < 2; ++n) { const f32x4 o = v[n] * oscale; u32x2 w; w.x = pk2(o[0], o[1]); w.y = pk2(o[2], o[3]); *(u32x2*)(outp + axis * 16 + n * 8 + fo) = w; }
}

struct EpiHeads0 {
    static constexpr bool PERM = false, AFTER_DRAIN = false;
    bf16_t* QK; const float* gains; const float* rope64; const float* RS; const float* bias;
    __device__ __forceinline__ void operator()(AccRef acc, const Unit& u, int wr, int wc, int fr, int fq) const {
        const int H = 4 * u.pn + wc; if (H >= 26) return;
        const float* gain = gains + (H >> 3) * 64; const float osc = H < 16 ? SC64 : 1.0f;
        const int row0 = u.pm * 256; const bool lat = row0 < NLAT;
        const float* bp = bias + (size_t)(lat ? (row0 >> 11) : 16) * 1792 + u.pn * 256 + wc * 32 + 4 * fq;
        const f32x4 b00 = *(const f32x4*)(bp), b01 = *(const f32x4*)(bp + 16), b10 = *(const f32x4*)(bp + 128), b11 = *(const f32x4*)(bp + 144);
        float rsv[8]; rows_rstd8(RS, row0 + wr * 64 + fr, fq, rsv);
#pragma unroll
        for (int ai = 0; ai < 2; ++ai)
#pragma unroll
            for (int m = 0; m < 4; ++m) { const int r = row0 + ai * 128 + wr * 64 + m * 16 + fr; const float rs = rsv[ai * 4 + m];
                head64_row(acc[ai][0][m][0] * rs + b00, acc[ai][0][m][1] * rs + b01, acc[ai][1][m][0] * rs + b10, acc[ai][1][m][1] * rs + b11, 1.0f, fq, gain, rope64, lat, r & 2047, osc, QK + (size_t)r * 1792 + H * 64); asm volatile("" ::: "memory"); }
    }
};

struct EpiHeads1 {
    static constexpr bool PERM = false, AFTER_DRAIN = false;
    bf16_t *QK, *CQ, *CKV, *KR; float *PQ, *PKV; const float *g_dq, *g_dk, *g_kr; const float* rope32; const float* RS; const float* bias;
    __device__ __forceinline__ void operator()(AccRef acc, const Unit& u, int wr, int wc, int fr, int fq) const {
        const int row0 = u.pm * 256; const bool lat = row0 < NLAT; const int pn = u.pn;
        if (pn == 8 && wc != 0) return;
        const float* bp = bias + (size_t)(lat ? (row0 >> 11) : 16) * 2304 + pn * 256 + wc * 32 + 4 * fq;
        const f32x4 b00 = *(const f32x4*)(bp), b01 = *(const f32x4*)(bp + 16), b10 = *(const f32x4*)(bp + 128), b11 = *(const f32x4*)(bp + 144);
        float rsv[8]; rows_rstd8(RS, row0 + wr * 64 + fr, fq, rsv);
        if (pn < 4) {
            const int H = 4 * pn + wc; const float* gain = H < 8 ? g_dq : g_dk; const float osc = H < 8 ? SC64 : 1.0f;
#pragma unroll
            for (int ai = 0; ai < 2; ++ai)
#pragma unroll
                for (int m = 0; m < 4; ++m) { const int r = row0 + ai * 128 + wr * 64 + m * 16 + fr; const float rs = rsv[ai * 4 + m];
                    head64_row(acc[ai][0][m][0] * rs + b00, acc[ai][0][m][1] * rs + b01, acc[ai][1][m][0] * rs + b10, acc[ai][1][m][1] * rs + b11, 1.0f, fq, gain, nullptr, false, 0, osc, QK + (size_t)r * 1024 + H * 64); asm volatile("" ::: "memory"); }
        } else if (pn < 8) {
            bf16_t* O = pn < 7 ? CQ : CKV; const int ldc = pn < 7 ? 768 : 256; const int colt = pn < 7 ? (pn - 4) * 256 : 0;
            float* Pp = pn < 7 ? PQ : PKV; const int pst = pn < 7 ? 12 : 4, pix = pn < 7 ? (pn - 4) * 4 + wc : wc;
#pragma unroll
            for (int ai = 0; ai < 2; ++ai)
#pragma unroll
                for (int m = 0; m < 4; ++m) { const int r = row0 + ai * 128 + wr * 64 + m * 16 + fr; const float rs = rsv[ai * 4 + m]; float ss = 0.f;
#pragma unroll
                    for (int bj = 0; bj < 2; ++bj)
#pragma unroll
                        for (int n = 0; n < 2; ++n) { const f32x4 v = acc[ai][bj][m][n] * rs + (bj == 0 ? (n == 0 ? b00 : b01) : (n == 0 ? b10 : b11)); ss += (v[0] * v[0] + v[1] * v[1]) + (v[2] * v[2] + v[3] * v[3]);
                            u32x2 w; w.x = pk2(v[0], v[1]); w.y = pk2(v[2], v[3]); *(u32x2*)(O + (size_t)r * ldc + colt + bj * 128 + wc * 32 + n * 16 + 4 * fq) = w; }
                    ss = swap_sum(swap16_sum(ss));
                    if (fq == 0) Pp[(size_t)r * pst + pix] = ss; asm volatile("" ::: "memory"); }
        } else {
#pragma unroll
            for (int ai = 0; ai < 2; ++ai)
#pragma unroll
                for (int m = 0; m < 4; ++m) { const int r = row0 + ai * 128 + wr * 64 + m * 16 + fr; const float rs = rsv[ai * 4 + m];
                    head32_row(acc[ai][0][m][0] * rs + b00, acc[ai][0][m][1] * rs + b01, 1.0f, fq, g_kr, rope32, lat, r & 2047, 1.0f, KR + (size_t)r * 32); asm volatile("" ::: "memory"); }
        }
    }
};

struct EpiUq {
    static constexpr bool PERM = false, AFTER_DRAIN = false;
    bf16_t* QC; const float* PQ; const float *g_nope, *g_rope; const float* rope32;
    __device__ __forceinline__ void operator()(AccRef acc, const Unit& u, int wr, int wc, int fr, int fq) const {
        const int row0 = u.pm * 256;
#pragma unroll
        for (int ai = 0; ai < 2; ++ai)
#pragma unroll
            for (int m = 0; m < 4; ++m) { const int r = row0 + ai * 128 + wr * 64 + m * 16 + fr;
                const f32x4 p0 = *(const f32x4*)(PQ + (size_t)r * 12), p1 = *(const f32x4*)(PQ + (size_t)r * 12 + 4), p2 = *(const f32x4*)(PQ + (size_t)r * 12 + 8);
                const float rs = __builtin_amdgcn_rsqf((((p0.x + p0.y) + (p0.z + p0.w)) + ((p1.x + p1.y) + (p1.z + p1.w)) + ((p2.x + p2.y) + (p2.z + p2.w))) * (1.0f / 768.0f) + EPS);
                if (u.pn < 2) { const int H = 4 * u.pn + wc;
                    head64_row(acc[ai][0][m][0], acc[ai][0][m][1], acc[ai][1][m][0], acc[ai][1][m][1], rs, fq, g_nope, nullptr, false, 0, SC96, QC + (size_t)r * 768 + H * 96); }
                else {
#pragma unroll
                    for (int bj = 0; bj < 2; ++bj) head32_row(acc[ai][bj][m][0], acc[ai][bj][m][1], rs, fq, g_rope, rope32, true, r & 2047, SC96, QC + (size_t)r * 768 + (4 * bj + wc) * 96 + 64); }
                asm volatile("" ::: "memory");
            }
    }
};

struct EpiUk {
    static constexpr bool PERM = false, AFTER_DRAIN = false;
    bf16_t* KC; const float* PKV; const float* g_nope;
    __device__ __forceinline__ void operator()(AccRef acc, const Unit& u, int wr, int wc, int fr, int fq) const {
        const int row0 = u.pm * 256; const int H = 4 * u.pn + wc;
#pragma unroll
        for (int ai = 0; ai < 2; ++ai)
#pragma unroll
            for (int m = 0; m < 4; ++m) { const int r = row0 + ai * 128 + wr * 64 + m * 16 + fr;
                const f32x4 p = *(const f32x4*)(PKV + (size_t)r * 4);
                const float rs = __builtin_amdgcn_rsqf(((p.x + p.y) + (p.z + p.w)) * (1.0f / 256.0f) + EPS);
                head64_row(acc[ai][0][m][0], acc[ai][0][m][1], acc[ai][1][m][0], acc[ai][1][m][1], rs, fq, g_nope, nullptr, false, 0, 1.0f, KC + (size_t)r * 512 + H * 64); asm volatile("" ::: "memory"); }
    }
};

struct OffOrder : pg8::StaticOrder {
    int p0;
    __device__ __forceinline__ bool next(int i, Unit& u) const { if (!pg8::StaticOrder::next(i, u)) return false; u.pm += p0; return true; }
};
template <class Epi> __device__ __forceinline__ void run_gemm(PG8_LAS unsigned char* lds, int wave_s, const bf16_t* A, const bf16_t* Bt, int M, int N, int K, const Epi& E, int rot = 0, int p0 = 0, int Gs = 0, int cs = -1) {
    int G = (int)gridDim.x, c = (int)blockIdx.x;
    if (Gs > 0) { G = Gs; c = cs; if (c < 0 || c >= G) return; }
    c += rot; c = c >= G ? c - G : c;
    pg8::Gemm g{A, Bt, M, N, K, K}; OffOrder S; S.init(M, N, G, c); S.p0 = p0;
    pg8::gemm_phase<Epi, OffOrder, true, true>(lds, g, S, E, wave_s);
}

__device__ __forceinline__ bf16_t* dst_row(unsigned char* ws, int mat, int n) {
    if (mat < 12) { const int l = mat / 6, f = (mat % 6) / 3, k = mat % 3, idx = l * 2 + f;
        if (k == 2) return (bf16_t*)(ws + OFF_WD + idx * SZ_WD) + (size_t)n * FF;
        return (bf16_t*)(ws + OFF_WGU + idx * SZ_WGU) + (size_t)(256 * (n >> 7) + (n & 127) + (k == 1 ? 128 : 0)) * DM; }
    if (mat == 12) {
        bf16_t* qk = (bf16_t*)(ws + OFF_WQK0); bf16_t* wv = (bf16_t*)(ws + OFF_WV0);
        if (n < 1024) return qk + (size_t)headperm(n >> 6, n & 63) * DM;
        if (n < 1152) return qk + (size_t)headperm(24 + ((n - 1024) >> 6), n & 63) * DM;
        if (n < 1280) return wv + (size_t)(n - 1152) * DM;
        if (n < 1792) return qk + (size_t)headperm(16 + ((n - 1280) >> 6), n & 63) * DM;
        return wv + (size_t)(128 + n - 1792) * DM;
    }
    if (mat == 13) return (bf16_t*)(ws + OFF_WOUT0) + (size_t)n * DM;
    if (mat == 14) {
        bf16_t* w = (bf16_t*)(ws + OFF_WIN1);
        if (n < 768) return w + (size_t)(1024 + n) * DM;
        if (n < 1280) return w + (size_t)headperm((n - 768) >> 6, n & 63) * DM;
        if (n < 1536) return w + (size_t)(1792 + n - 1280) * DM;
        if (n < 1568) return w + (size_t)(2048 + r32perm(n - 1536)) * DM;
        if (n < 2080) return w + (size_t)headperm(8 + ((n - 1568) >> 6), (n - 1568) & 63) * DM;
        return (bf16_t*)(ws + OFF_WDV) + (size_t)(n - 2080) * DM;
    }
    if (mat == 15) return (bf16_t*)(ws + OFF_WOUT1) + (size_t)n * DM;
    if (mat == 16) { const int h = n / 96, dd = n % 96; bf16_t* w = (bf16_t*)(ws + OFF_WUQ);
        if (dd < 64) return w + (size_t)headperm(h, dd) * 768;
        return w + (size_t)(512 + 128 * (h >> 2) + 32 * (h & 3) + r32perm(dd - 64)) * 768; }
    { const int h = n >> 7, dd = n & 127;
      if (dd < 64) return (bf16_t*)(ws + OFF_WUK) + (size_t)headperm(h, dd) * 256;
      return (bf16_t*)(ws + OFF_WUV) + (size_t)(h * 64 + dd - 64) * 256; }
}
__device__ __forceinline__ void transpose_item(const float* W, int K, int N, const float* kgain, unsigned char* ws, int mat, LAS float* scr, int item, int lane) {
    const int nblk = N / 32, kb = item / nblk, nb = item % nblk, k0 = 64 * kb, n0 = 32 * nb;
#pragma unroll 8
    for (int i = 0; i < 32; ++i) { const int kk = 2 * i + (lane >> 5); float v = W[(size_t)(k0 + kk) * N + n0 + (lane & 31)]; if (kgain) v *= kgain[k0 + kk]; scr[kk * 33 + (lane & 31)] = v; }
    asm volatile("s_waitcnt lgkmcnt(0)" ::: "memory");
    const int c = lane & 7;
#pragma unroll
    for (int j = 0; j < 4; ++j) { const int n = (lane >> 3) + 8 * j; const LAS float* s = scr + (8 * c) * 33 + n;
        u32x4 o; o.x = pk2(s[0 * 33], s[1 * 33]); o.y = pk2(s[2 * 33], s[3 * 33]); o.z = pk2(s[4 * 33], s[5 * 33]); o.w = pk2(s[6 * 33], s[7 * 33]);
        *(u32x4*)(dst_row(ws, mat, n0 + n) + k0 + 8 * c) = o; }
    asm volatile("s_waitcnt lgkmcnt(0)" ::: "memory");
}
__device__ __forceinline__ void sincos_d(double x, double& s, double& c) {
    const double k = __builtin_rint(x * 0.63661977236758134308); const double r = (x - k * 1.57079632679489655800) - k * 6.123233995736766036e-17; const double r2 = r * r;
    double sp = r * (1.0 + r2 * (-1.0 / 6 + r2 * (1.0 / 120 + r2 * (-1.0 / 5040 + r2 * (1.0 / 362880 + r2 * (-1.0 / 39916800 + r2 * (1.0 / 6227020800.0 + r2 * (-1.0 / 1307674368000.0))))))));
    double cp = 1.0 + r2 * (-0.5 + r2 * (1.0 / 24 + r2 * (-1.0 / 720 + r2 * (1.0 / 40320 + r2 * (-1.0 / 3628800 + r2 * (1.0 / 479001600.0 + r2 * (-1.0 / 87178291200.0 + r2 * (1.0 / 20922789888000.0))))))));
    const int q = ((int)k) & 3;
    s = (q == 0) ? sp : (q == 1) ? cp : (q == 2) ? -sp : -cp;
    c = (q == 0) ? cp : (q == 1) ? -sp : (q == 2) ? -cp : sp;
}
__device__ __forceinline__ int phase_tid(int wave_s) { unsigned z_; asm volatile("s_mov_b32 %0, 0" : "=s"(z_)); return (wave_s << 6) | (int)__builtin_amdgcn_mbcnt_hi(~0u, __builtin_amdgcn_mbcnt_lo(~0u, z_)); }
__device__ __forceinline__ void prologue(PP P, LAS unsigned char* lds, int wave_s) {
    const int tid = phase_tid(wave_s), lane = tid & 63, wave = wave_s;
    unsigned char* ws = P->ws;
    if (blockIdx.x == 0) {
        for (int i = tid; i < 64 * 16 + 64 * 8; i += 512) {
            const bool big = i < 1024; const int j = big ? i : i - 1024; const int nf = big ? 16 : 8, pos = j / nf, f = j % nf;
            const float inv = __builtin_amdgcn_exp2f(-(float)f / (float)nf * 13.287712379549449f);
            const float ang = (float)pos * inv; double s, c; sincos_d((double)ang, s, c);
            float* dst = (float*)(ws + (big ? OFF_ROPE64 : OFF_ROPE32)) + 2 * j; dst[0] = (float)c; dst[1] = (float)s;
        }
    }
    if (blockIdx.x == 1) {
        float* G = (float*)(ws + OFF_GAIN);
        if (tid < 64) G[tid] = P->in[14][tid]; else if (tid < 128) G[tid] = P->in[17][tid - 64]; else if (tid < 192) G[tid] = P->in[18][tid - 128]; else if (tid < 256) G[tid] = P->in[15][tid - 192];
    }
    {
        LAS float* act = (LAS float*)lds;
        LAS float* red = (LAS float*)(lds + 17 * 1024 * 4);
        for (int i = tid; i < 17 * 1024; i += 512) { const float v = i < 16 * 1024 ? P->in[1][i] : P->in[3][i - 16 * 1024]; act[i] = silu_f(v); }
        __syncthreads();
        float* MOD = (float*)(ws + OFF_MOD);
        for (int item = blockIdx.x; item < 2 * 144; item += gridDim.x) {
            const int l = item / 144, n0 = (item % 144) * 64, col = tid & 63, ks = tid >> 6;
            const float* w = P->in[4] + (size_t)l * DM * MODW + (size_t)(ks * 128) * MODW + n0 + col;
            float a[17];
#pragma unroll
            for (int j = 0; j < 17; ++j) a[j] = 0.f;
            for (int k = 0; k < 128; k += 4) {
                const float w0 = w[(size_t)k * MODW], w1 = w[(size_t)(k + 1) * MODW], w2 = w[(size_t)(k + 2) * MODW], w3 = w[(size_t)(k + 3) * MODW];
#pragma unroll
                for (int j = 0; j < 17; ++j) { const f32x4 x = *(const LAS f32x4*)(act + j * 1024 + ks * 128 + k); a[j] += (x[0] * w0 + x[1] * w1) + (x[2] * w2 + x[3] * w3); }
            }
#pragma unroll
            for (int j = 0; j < 17; ++j) red[(ks * 17 + j) * 64 + col] = a[j];
            __syncthreads();
            for (int i = tid; i < 17 * 64; i += 512) { const int j = i >> 6, cc = i & 63; float s = 0.f;
#pragma unroll
                for (int q = 0; q < 8; ++q) s += red[(q * 17 + j) * 64 + cc];
                MOD[((size_t)l * 17 + j) * MODW + n0 + cc] = s + P->in[5][(size_t)l * MODW + n0 + cc]; }
            __syncthreads();
        }
        __syncthreads();
    }
    {
        LAS float* scr = (LAS float*)(lds + wave * 16384);
        const int gw = blockIdx.x * NWAVES + wave, NGW = gridDim.x * NWAVES;
        constexpr int I_GU = 16 * 88, I_D = 44 * 32, I_ABIN = 16 * 72, I_O = 16 * 32, I_CDIN = 16 * 81, I_UQ = 12 * 24, I_UKV = 4 * 32;
        constexpr int NITEMS = 8 * I_GU + 4 * I_D + I_ABIN + 2 * I_O + I_CDIN + I_UQ + I_UKV;
        for (int it = gw; it < NITEMS; it += NGW) {
            int r = it;
            if (r < 12 * I_GU) {
                const int mat = r / I_GU, l = mat / 6, f = (mat % 6) / 3, k = mat % 3; r -= mat * I_GU;
                const float* src = P->in[6 + f * 3 + k] + (size_t)l * DM * FF;
                if (k == 2) transpose_item(src, FF, DM, nullptr, ws, mat, scr, r, lane); else transpose_item(src, DM, FF, nullptr, ws, mat, scr, r, lane);
                continue;
            }
            r -= 12 * I_GU;
            if (r < I_ABIN) { transpose_item(P->in[12], DM, 2304, nullptr, ws, 12, scr, r, lane); continue; } r -= I_ABIN;
            if (r < I_O) { transpose_item(P->in[13], DM, DM, nullptr, ws, 13, scr, r, lane); continue; } r -= I_O;
            if (r < I_CDIN) { transpose_item(P->in[24], DM, 2592, nullptr, ws, 14, scr, r, lane); continue; } r -= I_CDIN;
            if (r < I_O) { transpose_item(P->in[25], DM, DM, nullptr, ws, 15, scr, r, lane); continue; } r -= I_O;
            if (r < I_UQ) { transpose_item(P->in[28], 768, 768, P->in[26], ws, 16, scr, r, lane); continue; } r -= I_UQ;
            transpose_item(P->in[29], 256, 1024, P->in[27], ws, 17, scr, r, lane);
        }
    }
}
static_assert(16 * 88 == 44 * 32, "item counts");

__device__ __forceinline__ void prep_phase(PP P, LAS unsigned char* lds, int wave_s) {
    const int tid = phase_tid(wave_s), lane = tid & 63, wave = wave_s;
    unsigned char* ws = P->ws; const float* MOD = (const float*)(ws + OFF_MOD); float* BIAS = (float*)(ws + OFF_BIAS);
    LAS float* sh = (LAS float*)lds;
    for (int vb = blockIdx.x; vb < 256; vb += gridDim.x) {
        int c, i0, cnt;
        if (vb < 52) { c = 0; i0 = vb; cnt = 52; } else if (vb < 75) { c = 1; i0 = vb - 52; cnt = 23; } else if (vb < 127) { c = 2; i0 = vb - 75; cnt = 52; }
        else if (vb < 179) { c = 3; i0 = vb - 127; cnt = 52; } else if (vb < 204) { c = 4; i0 = vb - 179; cnt = 25; } else { c = 5; i0 = vb - 204; cnt = 52; }
        const int l = c / 3, kind = c % 3, a = kind * 3;
        __syncthreads();
        for (int i = tid; i < 17 * 1024; i += 512) sh[i] = MOD[((size_t)l * 17 + (i >> 10)) * MODW + a * DM + (i & 1023)];
        __syncthreads();
        const int ntot = kind != 1 ? 5632 : (l == 0 ? 2560 : 2816);
        for (int n = i0 * 8 + wave; n < ntot; n += cnt * 8) {
            const bf16_t* wrow; float* bout; int nb, nn;
            if (kind != 1) { wrow = (const bf16_t*)(ws + OFF_WGU + (size_t)(l * 2 + (kind >> 1)) * SZ_WGU) + (size_t)n * DM; bout = BIAS + BIAS_FFN + (l * 2 + (kind >> 1)) * 17 * 5632; nb = 5632; nn = n; }
            else if (l == 0) { if (n < 1792) { wrow = (const bf16_t*)(ws + OFF_WQK0) + (size_t)n * DM; bout = BIAS + BIAS_QK0; nb = 1792; nn = n; } else { wrow = (const bf16_t*)(ws + OFF_WV0) + (size_t)(n - 1792) * DM; bout = BIAS + BIAS_V0; nb = 768; nn = n - 1792; } }
            else { if (n < 2304) { wrow = (const bf16_t*)(ws + OFF_WIN1) + (size_t)n * DM; bout = BIAS + BIAS_IN1; nb = 2304; nn = n; } else { wrow = (const bf16_t*)(ws + OFF_WDV) + (size_t)(n - 2304) * DM; bout = BIAS + BIAS_DV; nb = 512; nn = n - 2304; } }
            float acc[17];
#pragma unroll
            for (int j = 0; j < 17; ++j) acc[j] = 0.f;
            u32x2 wq[4];
#pragma unroll
            for (int q = 0; q < 4; ++q) wq[q] = *(const u32x2*)(wrow + q * 256 + 4 * lane);
#pragma unroll
            for (int q = 0; q < 4; ++q) {
                const u32x2 wv = wq[q];
                const float w0 = __uint_as_float(wv.x << 16), w1 = __uint_as_float(wv.x & 0xffff0000u), w2 = __uint_as_float(wv.y << 16), w3 = __uint_as_float(wv.y & 0xffff0000u);
#pragma unroll
                for (int j = 0; j < 17; ++j) { const f32x4 s = *(const LAS f32x4*)(sh + j * 1024 + q * 256 + 4 * lane); acc[j] += (s[0] * w0 + s[1] * w1) + (s[2] * w2 + s[3] * w3); }
                asm volatile("" ::: "memory");
            }
#pragma unroll
            for (int j = 0; j < 17; ++j) acc[j] = wave_sum(acc[j], lane);
            if (lane == 0) {
#pragma unroll
                for (int j = 0; j < 17; ++j) bout[(size_t)j * nb + nn] = acc[j];
            }
        }
    }
    {
        const float* mod0 = MOD; bf16_t* H = (bf16_t*)(ws + OFF_H); float* RS = (float*)(ws + OFF_RS); float* XC = (float*)(ws + OFF_XCTX);
        const int gw = blockIdx.x * NWAVES + wave, NGW = gridDim.x * NWAVES;
        for (int row = gw; row < T; row += NGW) {
            const bool lat = row < NLAT; const int bidx = lat ? (row >> 11) : 16;
            const f32x4* xr = (const f32x4*)(lat ? P->in[0] + (size_t)row * DM : P->in[2] + (size_t)(row - NLAT) * DM) + lane;
            const f32x4* sc = (const f32x4*)(mod0 + (size_t)bidx * MODW + DM) + lane;
            f32x4 v[4]; float s = 0.f;
#pragma unroll
            for (int j = 0; j < 4; ++j) { v[j] = xr[64 * j]; s += (v[j][0] * v[j][0] + v[j][1] * v[j][1]) + (v[j][2] * v[j][2] + v[j][3] * v[j][3]); }
            if (!lat) { f32x4* xc = (f32x4*)(XC + (size_t)(row - NLAT) * DM) + lane;
#pragma unroll
                for (int j = 0; j < 4; ++j) xc[64 * j] = v[j]; }
            s = wave_sum(s, lane);
            if (lane < 16) RS[(size_t)row * 16 + lane] = lane == 0 ? s : 0.f;
            u32x2* o = (u32x2*)(H + (size_t)row * DM) + lane;
#pragma unroll
            for (int j = 0; j < 4; ++j) { const f32x4 r = v[j] * (sc[64 * j] + 1.0f); u32x2 w; w.x = pk2(r[0], r[1]); w.y = pk2(r[2], r[3]); o[64 * j] = w; }
        }
    }
}


struct AttnArgs {
    const bf16_t* q;
    const bf16_t* k0; int ld0;
    const bf16_t* k1;
    const bf16_t* vt;
    int ctx_tok, lat_tok, t_lo, t_hi;
    int w_lo, w_hi;
    int qpos;
    int qrow;
    const float* rpb;
};
constexpr int KSTR64 = 144, KSTR96 = 208, VSTR = 144;
constexpr int A_KB = 13312, A_VB = 18432, A_K0 = 0, A_V0 = 2 * A_KB, A_STASH = 2 * A_KB + 3 * A_VB;
static_assert(A_STASH + 8 * 8192 <= LDSCTL_OFF, "attention LDS map");
__device__ __forceinline__ void lds_rd128(bf16x8& d, unsigned addr, int off) { asm volatile("ds_read_b128 %0, %1 offset:%c2" : "=&v"(d) : "v"(addr), "i"(off) : "memory"); }
template <int N> __device__ __forceinline__ void lds_wait(bf16x8& a, bf16x8& b) { asm volatile("s_waitcnt lgkmcnt(%c2)" : "+v"(a), "+v"(b) : "i"(N) : "memory"); }
template <int N> __device__ __forceinline__ void lds_wait(bf16x8& a, bf16x8& b, bf16x8& c, bf16x8& d) { asm volatile("s_waitcnt lgkmcnt(%c4)" : "+v"(a), "+v"(b), "+v"(c), "+v"(d) : "i"(N) : "memory"); }
template <int NDB> __device__ __forceinline__ void pv_tile(f32x16 (&o)[NDB], unsigned va, const u32x4 (&pw)[4]) {
    if constexpr (NDB == 2) {
        bf16x8 v[4][2];
#pragma unroll
        for (int s = 0; s < 4; ++s)
#pragma unroll
            for (int db = 0; db < 2; ++db) lds_rd128(v[s][db], va, (32 * db) * VSTR + 32 * s);
        lds_wait<4>(v[0][0], v[0][1], v[1][0], v[1][1]);
#pragma unroll
        for (int s = 0; s < 2; ++s)
#pragma unroll
            for (int db = 0; db < 2; ++db) o[db] = __builtin_amdgcn_mfma_f32_32x32x16_bf16(v[s][db], __builtin_bit_cast(bf16x8, pw[s]), o[db], 0, 0, 0);
        lds_wait<0>(v[2][0], v[2][1], v[3][0], v[3][1]);
#pragma unroll
        for (int s = 2; s < 4; ++s)
#pragma unroll
            for (int db = 0; db < 2; ++db) o[db] = __builtin_amdgcn_mfma_f32_32x32x16_bf16(v[s][db], __builtin_bit_cast(bf16x8, pw[s]), o[db], 0, 0, 0);
    } else {
#pragma unroll
        for (int s0 = 0; s0 < 4; s0 += 2) {
            bf16x8 v[2][4];
#pragma unroll
            for (int s = 0; s < 2; ++s)
#pragma unroll
                for (int db = 0; db < 4; ++db) lds_rd128(v[s][db], va, (32 * db) * VSTR + 32 * (s0 + s));
            lds_wait<4>(v[0][0], v[0][1], v[0][2], v[0][3]);
#pragma unroll
            for (int db = 0; db < 4; ++db) o[db] = __builtin_amdgcn_mfma_f32_32x32x16_bf16(v[0][db], __builtin_bit_cast(bf16x8, pw[s0]), o[db], 0, 0, 0);
            lds_wait<0>(v[1][0], v[1][1], v[1][2], v[1][3]);
#pragma unroll
            for (int db = 0; db < 4; ++db) o[db] = __builtin_amdgcn_mfma_f32_32x32x16_bf16(v[1][db], __builtin_bit_cast(bf16x8, pw[s0 + 1]), o[db], 0, 0, 0);
        }
    }
}
template <int NS, int NDB, int MODE>
__device__ __forceinline__ void attn_run(f32x16 (&o)[NDB], float& mrun, float& lrun, const AttnArgs& A, LAS unsigned char* lds, int tid, int r32, int hi) {
    constexpr int KSTR = NS == 6 ? KSTR96 : KSTR64;
    const int pi = (r32 & 0x13) | ((r32 & 4) << 1) | ((r32 & 8) >> 1);
    bf16x8 qf[NS];
#pragma unroll
    for (int s = 0; s < NS; ++s) qf[s] = *(const bf16x8*)(A.q + 16 * s);
    const int ntile = 4 + (A.t_hi - A.t_lo);
    u32x4 sk, sk1, sv[NDB / 2];
    const int srow = tid >> 3, sch = tid & 7;
    const int koffl = (srow * A.ld0 + sch * 8) * 2, voffl = (srow * T + sch * 8) * 2, k1offl = ((tid >> 2) * 32 + (tid & 3) * 8) * 2;
    const __amdgpu_buffer_rsrc_t rk = __builtin_amdgcn_make_buffer_rsrc((void*)A.k0, (short)0, 0x7fffffff, 0x00020000);
    const __amdgpu_buffer_rsrc_t rv = __builtin_amdgcn_make_buffer_rsrc((void*)A.vt, (short)0, 0x7fffffff, 0x00020000);
    const __amdgpu_buffer_rsrc_t rk1 = __builtin_amdgcn_make_buffer_rsrc((void*)(NS == 6 ? A.k1 : A.k0), (short)0, 0x7fffffff, 0x00020000);
#define ATT_LOAD(tok) do { sk = __builtin_amdgcn_raw_buffer_load_b128(rk, koffl, (tok) * A.ld0 * 2, 0); \
        if (NS == 6) { if (tid < 256) sk1 = __builtin_amdgcn_raw_buffer_load_b128(rk1, k1offl, (tok) * 64, 0); } \
        _Pragma("unroll") for (int p = 0; p < NDB / 2; ++p) sv[p] = __builtin_amdgcn_raw_buffer_load_b128(rv, voffl, (p * 64 * T + (tok)) * 2, 0); } while (0)
#define ATT_WRITE(b, vb3) do { *(LAS u32x4*)(lds + A_K0 + (b) * A_KB + srow * KSTR + sch * 16) = sk; \
        if (NS == 6) { if (tid < 256) *(LAS u32x4*)(lds + A_K0 + (b) * A_KB + (tid >> 2) * KSTR + 128 + (tid & 3) * 16) = sk1; } \
        _Pragma("unroll") for (int p = 0; p < NDB / 2; ++p) *(LAS u32x4*)(lds + A_V0 + (vb3) * A_VB + (p * 64 + srow) * VSTR + sch * 16) = sv[p]; } while (0)
    ATT_LOAD(A.ctx_tok);
    const int kro = pi * KSTR + 16 * hi, vro = r32 * VSTR + 16 * hi;
    const int grp = __builtin_amdgcn_readfirstlane(tid >> 8);
    u32x4 pw[4]; bool have_prev = false; int vb3 = 0;
    f32x16 negm;
#pragma unroll
    for (int i = 0; i < 16; ++i) negm[i] = -mrun;
#define ATT_PV(vbi) pv_tile<NDB>(o, (unsigned)(size_t)(lds + A_V0 + (vbi) * A_VB + vro), pw)
    for (int j = 0; j < ntile; ++j) {
        const int b = j & 1;
        ATT_WRITE(b, vb3);
        __syncthreads();
        if (j + 1 < ntile) { const int jn = j + 1; const int tokn = jn < 4 ? A.ctx_tok + 64 * jn : A.lat_tok + 64 * (A.t_lo + jn - 4); ATT_LOAD(tokn); }
        if (grp == 1 && have_prev) { const int vp = vb3 == 0 ? 2 : vb3 - 1; ATT_PV(vp); have_prev = false; }
        const int t = A.t_lo + j - 4;
        if (!(j >= 4 && (t < A.w_lo || t >= A.w_hi))) {
        const LAS unsigned char* kb = lds + A_K0 + b * A_KB + kro;
        f32x16 st0 = negm, st1 = negm;
        { bf16x8 kfa[NS], kfc[NS]; const unsigned ka_ = (unsigned)(size_t)kb;
#pragma unroll
          for (int s = 0; s < NS; ++s) { lds_rd128(kfa[s], ka_, 32 * s); lds_rd128(kfc[s], ka_, 32 * KSTR + 32 * s); }
          lds_wait<2 * NS - 4>(kfa[0], kfc[0], kfa[1], kfc[1]);
#pragma unroll
          for (int s = 0; s < 2; ++s) { st0 = __builtin_amdgcn_mfma_f32_32x32x16_bf16(kfa[s], qf[s], st0, 0, 0, 0); st1 = __builtin_amdgcn_mfma_f32_32x32x16_bf16(kfc[s], qf[s], st1, 0, 0, 0); }
          lds_wait<2 * NS - 8>(kfa[2], kfc[2], kfa[3], kfc[3]);
#pragma unroll
          for (int s = 2; s < 4; ++s) { st0 = __builtin_amdgcn_mfma_f32_32x32x16_bf16(kfa[s], qf[s], st0, 0, 0, 0); st1 = __builtin_amdgcn_mfma_f32_32x32x16_bf16(kfc[s], qf[s], st1, 0, 0, 0); }
          if constexpr (NS == 6) { lds_wait<0>(kfa[4], kfc[4], kfa[5], kfc[5]);
#pragma unroll
              for (int s = 4; s < 6; ++s) { st0 = __builtin_amdgcn_mfma_f32_32x32x16_bf16(kfa[s], qf[s], st0, 0, 0, 0); st1 = __builtin_amdgcn_mfma_f32_32x32x16_bf16(kfc[s], qf[s], st1, 0, 0, 0); } }
          }
        if (MODE == 1 && j >= 4) {
            const int kp0 = 64 * t + 8 * hi;
#pragma unroll
            for (int i = 0; i < 16; ++i) { const int d = A.qpos - (kp0 + (i & 7) + 16 * (i >> 3)); if (d > 128 || d < -128) st0[i] = NEGV; if (d - 32 > 128 || d - 32 < -128) st1[i] = NEGV; }
        }
        if (MODE == 2 && j >= 4) {
            const int cs = min(max(A.qpos - 8, 0), 48); const LAS float* bp = (const LAS float*)(lds + A_STASH) + (t - A.qrow + 7) * 128 + (63 + 8 * hi - A.qpos);
#pragma unroll
            for (int i = 0; i < 16; ++i) { const int kk = (i & 7) + 16 * (i >> 3); const int kc = 8 * hi + kk;
                const float b0 = bp[kk], b1 = bp[kk + 32];
                st0[i] += b0 + (((unsigned)(kc - cs) < 16u) ? 0.f : NEGV); st1[i] += b1 + (((unsigned)(kc + 32 - cs) < 16u) ? 0.f : NEGV); }
        }
        asm volatile("s_nop 15\n\ts_nop 7" : "+v"(st0), "+v"(st1));
        float mx = max3f(st0[0], st1[0], st0[1]), mx2 = max3f(st1[1], st0[2], st1[2]);
#pragma unroll
        for (int i = 3; i < 15; i += 2) { mx = max3f(mx, st0[i], st1[i]); mx2 = max3f(mx2, st0[i + 1], st1[i + 1]); }
        mx = max3f(mx, mx2, st0[15]); mx = max3f(mx, st1[15], mx);
        mx = swap_max(mx);
        if (j == 0 || __any(mx > 8.0f)) {
            const float dl = j == 0 ? mx : fmaxf(mx, 0.f); mrun += dl;
#pragma unroll
            for (int i = 0; i < 16; ++i) { st0[i] -= dl; st1[i] -= dl; negm[i] = -mrun; }
            const float f = __builtin_amdgcn_exp2f(-dl); lrun *= f;
#pragma unroll
            for (int db = 0; db < NDB; ++db)
#pragma unroll
                for (int i = 0; i < 16; ++i) o[db][i] *= f;
        }
        float ps = 0.f;
#pragma unroll
        for (int i = 0; i < 16; ++i) { st0[i] = __builtin_amdgcn_exp2f(st0[i]); st1[i] = __builtin_amdgcn_exp2f(st1[i]); ps += st0[i] + st1[i]; }
        lrun += ps;
#pragma unroll
        for (int s = 0; s < 2; ++s) { pw[s].x = pk2(st0[8 * s], st0[8 * s + 1]); pw[s].y = pk2(st0[8 * s + 2], st0[8 * s + 3]); pw[s].z = pk2(st0[8 * s + 4], st0[8 * s + 5]); pw[s].w = pk2(st0[8 * s + 6], st0[8 * s + 7]);
            pw[2 + s].x = pk2(st1[8 * s], st1[8 * s + 1]); pw[2 + s].y = pk2(st1[8 * s + 2], st1[8 * s + 3]); pw[2 + s].z = pk2(st1[8 * s + 4], st1[8 * s + 5]); pw[2 + s].w = pk2(st1[8 * s + 6], st1[8 * s + 7]); }
        if (grp == 0) ATT_PV(vb3); else have_prev = true;
        }
        vb3 = vb3 == 2 ? 0 : vb3 + 1;
    }
    if (grp == 1 && have_prev) { const int vp = vb3 == 0 ? 2 : vb3 - 1; ATT_PV(vp); }
    __syncthreads();
#undef ATT_PV
#undef ATT_LOAD
#undef ATT_WRITE
}
template <int NDB> __device__ __forceinline__ void attn_store(const f32x16 (&o)[NDB], float sc, bf16_t* yp, int hi) {
#pragma unroll
    for (int db = 0; db < NDB; ++db)
#pragma unroll
        for (int g = 0; g < 4; ++g) { u32x2 w; w.x = pk2(o[db][4 * g] * sc, o[db][4 * g + 1] * sc); w.y = pk2(o[db][4 * g + 2] * sc, o[db][4 * g + 3] * sc); *(u32x2*)(yp + 32 * db + 8 * g + 4 * hi) = w; }
}

__device__ __forceinline__ void unit_A(PP P, int b, int hq, int qb, bool latq, int tid, int wave, LAS unsigned char* lds) {
    tid = phase_tid(wave);
    const int lane = tid & 63, r32 = lane & 31, hi = lane >> 5; unsigned char* ws = P->ws;
    const bf16_t* QK = (const bf16_t*)(ws + OFF_QK0); const bf16_t* VT = (const bf16_t*)(ws + OFF_VT0); bf16_t* Y = (bf16_t*)(ws + OFF_Y);
    const int kvh = hq >> 2; const int qp0 = qb * 256 + wave * 32; const int qtok = (latq ? b * SEQ : NLAT + b * CTXL) + qp0 + r32;
    AttnArgs A; A.q = QK + (size_t)qtok * 1792 + hq * 64 + 8 * hi; A.k0 = QK + (24 + kvh) * 64; A.ld0 = 1792; A.k1 = nullptr;
    A.vt = VT + (size_t)(kvh * 64) * T; A.ctx_tok = NLAT + b * CTXL; A.lat_tok = b * SEQ;
    A.t_lo = latq ? max(4 * qb - 2, 0) : 0; A.t_hi = latq ? min(4 * qb + 6, 32) : 0;
    A.w_lo = (max(qp0 - 128, 0)) >> 6; A.w_hi = ((min(qp0 + 31 + 128, SEQ - 1)) >> 6) + 1;
    A.qpos = qp0 + r32; A.qrow = 0; A.rpb = nullptr;
    f32x16 o[2]; o[0] = f32x16{}; o[1] = f32x16{}; float m = 0.f, l = 0.f;
    attn_run<4, 2, 1>(o, m, l, A, lds, tid, r32, hi);
    l = swap_sum(l) + __builtin_amdgcn_exp2f(P->in[16][hq] * LOG2E - m);
    attn_store<2>(o, 1.0f / l, Y + (size_t)qtok * DM + hq * 64, hi);
}
__device__ __forceinline__ void unit_B(PP P, int b, int h, int qb, bool latq, int tid, int wave, LAS unsigned char* lds, float lam) {
    tid = phase_tid(wave);
    const int lane = tid & 63, r32 = lane & 31, hi = lane >> 5; unsigned char* ws = P->ws;
    const bf16_t* QK = (const bf16_t*)(ws + OFF_QK0); const bf16_t* VT = (const bf16_t*)(ws + OFF_VT0); bf16_t* Y = (bf16_t*)(ws + OFF_Y);
    const int qtok = (latq ? b * SEQ : NLAT + b * CTXL) + qb * 256 + wave * 32 + r32;
    LAS unsigned* stash = (LAS unsigned*)(lds + A_STASH + wave * 8192);
    f32x16 o[4];
#pragma unroll 1
    for (int mp = 1; mp >= 0; --mp) {
        AttnArgs A; A.q = QK + (size_t)qtok * 1792 + (8 + 2 * h + mp) * 64 + 8 * hi; A.k0 = QK + (16 + 2 * h + mp) * 64; A.ld0 = 1792; A.k1 = nullptr;
        A.vt = VT + (size_t)(128 + h * 128) * T; A.ctx_tok = NLAT + b * CTXL; A.lat_tok = b * SEQ; A.t_lo = 0; A.t_hi = latq ? 32 : 0; A.w_lo = 0; A.w_hi = 32; A.qpos = 0; A.qrow = 0; A.rpb = nullptr;
#pragma unroll
        for (int db = 0; db < 4; ++db) o[db] = f32x16{};
        float m = 0.f, l = 0.f;
        attn_run<4, 4, 0>(o, m, l, A, lds, tid, r32, hi);
        const float inv = 1.0f / swap_sum(l);
        if (mp == 1) {
#pragma unroll
            for (int db = 0; db < 4; ++db)
#pragma unroll
                for (int i = 0; i < 8; ++i) stash[(db * 8 + i) * 64 + lane] = pk2(o[db][2 * i] * inv, o[db][2 * i + 1] * inv);
        } else {
            float ss = 0.f;
#pragma unroll
            for (int db = 0; db < 4; ++db)
#pragma unroll
                for (int i = 0; i < 8; ++i) { const unsigned w = stash[(db * 8 + i) * 64 + lane];
                    const float v0 = o[db][2 * i] * inv - lam * __uint_as_float(w << 16), v1 = o[db][2 * i + 1] * inv - lam * __uint_as_float(w & 0xffff0000u);
                    o[db][2 * i] = v0; o[db][2 * i + 1] = v1; ss += v0 * v0 + v1 * v1; }
            ss = swap_sum(ss);
            const float rstd = __builtin_amdgcn_rsqf(ss * (1.0f / 128.0f) + EPS) * 0.8f;
            const int t2 = phase_tid(wave), hi2 = (t2 >> 5) & 1; const int qt2 = (latq ? b * SEQ : NLAT + b * CTXL) + qb * 256 + wave * 32 + (t2 & 31);
            const float* gn = P->in[23]; bf16_t* yp = Y + (size_t)qt2 * DM + 512 + h * 128;
#pragma unroll
            for (int db = 0; db < 4; ++db)
#pragma unroll
                for (int g = 0; g < 4; ++g) { const int d0 = 32 * db + 8 * g + 4 * hi2; const f32x4 gg = *(const f32x4*)(gn + d0);
                    u32x2 w; w.x = pk2(o[db][4 * g] * rstd * gg[0], o[db][4 * g + 1] * rstd * gg[1]); w.y = pk2(o[db][4 * g + 2] * rstd * gg[2], o[db][4 * g + 3] * rstd * gg[3]); *(u32x2*)(yp + d0) = w; }
        }
    }
}
__device__ __forceinline__ void unit_C(PP P, int b, int h, int qb, int tid, int wave, LAS unsigned char* lds) {
    tid = phase_tid(wave);
    const int lane = tid & 63, r32 = lane & 31, hi = lane >> 5; unsigned char* ws = P->ws;
    const int qtok = b * SEQ + qb * 256 + wave * 32 + r32;
    AttnArgs A; A.q = (const bf16_t*)(ws + OFF_QC) + (size_t)qtok * 768 + h * 96 + 8 * hi; A.k0 = (const bf16_t*)(ws + OFF_KC) + h * 64; A.ld0 = 512;
    A.k1 = (const bf16_t*)(ws + OFF_KR); A.vt = (const bf16_t*)(ws + OFF_CVT) + (size_t)(h * 64) * T;
    A.ctx_tok = NLAT + b * CTXL; A.lat_tok = b * SEQ; A.t_lo = 0; A.t_hi = 32; A.w_lo = 0; A.w_hi = 32; A.qpos = 0; A.qrow = 0; A.rpb = nullptr;
    f32x16 o[2]; o[0] = f32x16{}; o[1] = f32x16{}; float m = 0.f, l = 0.f;
    attn_run<6, 2, 0>(o, m, l, A, lds, tid, r32, hi);
    attn_store<2>(o, 1.0f / swap_sum(l), (bf16_t*)(ws + OFF_Y) + (size_t)qtok * DM + h * 64, hi);
}
__device__ __forceinline__ void unit_D(PP P, int b, int h, int qb, int tid, int wave, LAS unsigned char* lds) {
    tid = phase_tid(wave);
    const int lane = tid & 63, r32 = lane & 31, hi = lane >> 5; unsigned char* ws = P->ws;
    const int qtok = b * SEQ + qb * 256 + wave * 32 + r32; const bf16_t* QK = (const bf16_t*)(ws + OFF_QK1);
    const int qrow = 4 * qb + (wave >> 1), rs = min(max(qrow - 4, 0), 24);
    AttnArgs A; A.q = QK + (size_t)qtok * 1024 + h * 64 + 8 * hi; A.k0 = QK + 512 + h * 64; A.ld0 = 1024; A.k1 = nullptr;
    A.vt = (const bf16_t*)(ws + OFF_DVT) + (size_t)(h * 64) * T; A.ctx_tok = NLAT + b * CTXL; A.lat_tok = b * SEQ;
    A.t_lo = min(max(4 * qb - 4, 0), 24); A.t_hi = min(max(4 * qb + 3 - 4, 0), 24) + 8; A.w_lo = rs; A.w_hi = rs + 8;
    A.qpos = (wave & 1) * 32 + r32; A.qrow = qrow; A.rpb = nullptr;
    { const float* rp = P->in[36] + h * 15 * 31; LAS float* tb = (LAS float*)(lds + A_STASH);
      for (int i = tid; i < 15 * 128; i += 512) tb[i] = rp[(i >> 7) * 31 + min(max((i & 127) - 48, 0), 30)] * LOG2E; }
    f32x16 o[2]; o[0] = f32x16{}; o[1] = f32x16{}; float m = 0.f, l = 0.f;
    attn_run<4, 2, 2>(o, m, l, A, lds, tid, r32, hi);
    attn_store<2>(o, 1.0f / swap_sum(l), (bf16_t*)(ws + OFF_Y) + (size_t)qtok * DM + 512 + h * 64, hi);
}
__device__ __forceinline__ void attn_phase(PP P, int layer, LAS unsigned char* lds, int wave_s) {
    const int tid = phase_tid(wave_s), lane = tid & 63, wave = wave_s;
    const int G = gridDim.x; const int bx = (G % 8 == 0) ? ((int)blockIdx.x % 8) * (G / 8) + (int)blockIdx.x / 8 : (int)blockIdx.x;
    if (layer == 0) {
        const float d1 = wave_sum(P->in[19][lane] * P->in[20][lane], lane), d2 = wave_sum(P->in[21][lane] * P->in[22][lane], lane);
        const float lam = __expf(d1) - __expf(d2) + 0.2f;
#ifndef NO_UB
        for (int u = bx; u < 512; u += G) unit_B(P, u >> 5, (u >> 3) & 3, u & 7, true, tid, wave, lds, lam);
#endif
#ifndef NO_UA
        for (int u = bx; u < 1024; u += G) unit_A(P, u >> 6, (u >> 3) & 7, u & 7, true, tid, wave, lds);
#endif
#ifndef NO_UB
        for (int u = bx; u < 64; u += G) unit_B(P, u >> 2, u & 3, 0, false, tid, wave, lds, lam);
#endif
#ifndef NO_UA
        for (int u = bx - 64; u < 128; u += G) if (u >= 0) unit_A(P, u >> 3, u & 7, 0, false, tid, wave, lds);
#endif
    } else {
#ifndef NO_UC
        for (int u = bx; u < 1024; u += G) unit_C(P, u >> 6, (u >> 3) & 7, u & 7, tid, wave, lds);
#endif
#ifndef NO_UD
        for (int u = bx; u < 1024; u += G) unit_D(P, u >> 6, (u >> 3) & 7, u & 7, tid, wave, lds);
#endif
    }
}

#define XB_TMO      128
#define XB_XCNT(j)  (256  + 64 * (j))
#define XB_XSUB(j)  (1280 + 64 * (j))
#define XB_XGEN(j)  (2304 + 64 * (j))
#define XB_TOP      3328
#define XB_TOPGEN   3392
#define XCD_BAR_WORDS 3456
#define XB_SPIN_CAP (1u << 18)

__device__ __forceinline__ unsigned xb_ld(unsigned* p)              { return __hip_atomic_load(p, __ATOMIC_RELAXED, __HIP_MEMORY_SCOPE_AGENT); }
__device__ __forceinline__ unsigned xb_add(unsigned* p, unsigned v) { return __hip_atomic_fetch_add(p, v, __ATOMIC_RELAXED, __HIP_MEMORY_SCOPE_AGENT); }
__device__ __forceinline__ unsigned xb_xcc_id() { return (unsigned)__builtin_amdgcn_s_getreg((3 << 11) | 20) & 0xFu; }
#define XB_SPIN(cond, bar) do { unsigned _sp = 0; while (cond) { __builtin_amdgcn_s_sleep(1); \
    if ((++_sp & 255u) == 0u) { if (xb_ld(&(bar)[XB_TMO])) break; if (_sp > XB_SPIN_CAP) { atomicAdd(&(bar)[XB_TMO], 1u); break; } } } } while (0)

struct XcdBarrier {
    unsigned* bar; unsigned x;
    volatile LAS unsigned* st;
    int w;
};
__device__ __forceinline__ bool xb_t0(int w) { unsigned z_; asm volatile("s_mov_b32 %0, 0" : "=s"(z_)); return w == 0 && __builtin_amdgcn_mbcnt_hi(~0u, __builtin_amdgcn_mbcnt_lo(~0u, z_)) == 0u; }

__device__ __forceinline__ XcdBarrier xcd_barrier_post(unsigned* bar, volatile LAS unsigned* st, int w) {
    XcdBarrier b; b.bar = bar; b.x = xb_xcc_id(); b.st = st; b.w = w;
    if (xb_t0(w)) (void)xb_add(&bar[XB_XCNT(b.x)], 1u);
    return b;
}
__device__ __forceinline__ void xcd_barrier_complete(unsigned* bar, unsigned x, unsigned& nloc, unsigned& nx) {
    const unsigned G = gridDim.x * gridDim.y * gridDim.z;
    unsigned sum, cnt, mine, sp = 0u;
    for (;;) {
        sum = 0u; cnt = 0u; mine = 0u;
#pragma unroll
        for (unsigned j = 0; j < 16; ++j) { const unsigned c = xb_ld(&bar[XB_XCNT(j)]); sum += c; cnt += (c > 0u) ? 1u : 0u; mine = (j == x) ? c : mine; }
        if (sum == G) break;
        __builtin_amdgcn_s_sleep(1);
        if ((++sp & 255u) == 0u) { if (xb_ld(&bar[XB_TMO])) break; if (sp > XB_SPIN_CAP) { atomicAdd(&bar[XB_TMO], 1u); break; } }
    }
    nloc = mine > 0u ? mine : 1u; nx = cnt > 0u ? cnt : 1u;
}

__device__ __forceinline__ void xcd_barrier(const XcdBarrier& b) {
    asm volatile("s_waitcnt vmcnt(0)" ::: "memory");
    __syncthreads();
    if (xb_t0(b.w)) {
        unsigned* bar = b.bar;
        __builtin_amdgcn_s_waitcnt(0);
        unsigned nloc = b.st[0], nx = b.st[1];
        if (nloc == 0u) { xcd_barrier_complete(bar, b.x, nloc, nx); b.st[0] = nloc; b.st[1] = nx; }
        const unsigned old = xb_add(&bar[XB_XSUB(b.x)], 1u);
        const unsigned gen = old / nloc;
        if (old + 1u == (gen + 1u) * nloc) {
            __builtin_amdgcn_fence(__ATOMIC_RELEASE, "agent");
            asm volatile("s_waitcnt vmcnt(0)" ::: "memory");
            const unsigned og = xb_add(&bar[XB_TOP], 1u);
            const unsigned tg = og / nx;
            if (og + 1u == (tg + 1u) * nx) xb_add(&bar[XB_TOPGEN], 1u);
            else XB_SPIN(xb_ld(&bar[XB_TOPGEN]) == tg, bar);
            __builtin_amdgcn_fence(__ATOMIC_ACQUIRE, "agent");
            xb_add(&bar[XB_XGEN(b.x)], 1u);
            asm volatile("s_waitcnt vmcnt(0)" ::: "memory");
        } else {
            XB_SPIN(xb_ld(&bar[XB_XGEN(b.x)]) == gen, bar);
            __builtin_amdgcn_fence(__ATOMIC_ACQUIRE, "agent");
            asm volatile("s_waitcnt vmcnt(0)" ::: "memory");
        }
    }
    __syncthreads();
}

__global__ void __launch_bounds__(NWAVES * 64, 2) fwd_megakernel(Params Parg) {
    PP P = (PP)__builtin_amdgcn_kernarg_segment_ptr();
    extern __shared__ __attribute__((aligned(16))) unsigned char lds_raw[];
    LAS unsigned char* lds = (LAS unsigned char*)lds_raw;
    cg::grid_group grid = cg::this_grid();
    const int wave_s = __builtin_amdgcn_readfirstlane(threadIdx.x >> 6);
    { volatile LAS unsigned* mz = (volatile LAS unsigned*)(lds + LDSCTL_OFF); if (wave_s == 0) mz[phase_tid(0)] = 0u; }
    __syncthreads();
    XcdBarrier bar = xcd_barrier_post((unsigned*)(((PP)__builtin_amdgcn_kernarg_segment_ptr())->ws + OFF_CTL), (volatile LAS unsigned*)(lds + LDSCTL_OFF) + 8, wave_s);

#ifndef NO_PRO
    prologue(P, lds, wave_s);
#endif
#ifdef PROBE_PRO2
    __syncthreads(); prologue(P, lds, wave_s);
#endif
    grid.sync();
    prep_phase(P, lds, wave_s);
    xcd_barrier(bar);
#pragma unroll 1
    for (int st = 0; st < 6; ++st) {
        asm volatile("" : "+s"(P));
        unsigned char* ws = P->ws;
        const float* BIAS = (const float*)(ws + OFF_BIAS); float* RS = (float*)(ws + OFF_RS);
        bf16_t* H = (bf16_t*)(ws + OFF_H); bf16_t* Y = (bf16_t*)(ws + OFF_Y); bf16_t* ACT = (bf16_t*)(ws + OFF_ACT);
        float* XL = P->out;
        const float* rope64 = (const float*)(ws + OFF_ROPE64); const float* rope32 = (const float*)(ws + OFF_ROPE32);
        const int l = st / 3, ph = st % 3; const int G = (int)gridDim.x, bx = (int)blockIdx.x;
        const bool tail = st >= 1 && st <= 4;
        const int nsub = tail ? min(64, G >> 1) : 0;
        const int P0 = tail ? (st == 1 ? 82 : st == 2 ? 8 : st == 3 ? 17 : 64) : 0;
        const int npan = (st == 5) ? NLAT / 256 : T / 256;
#pragma unroll 1
        for (int part = 0; part < 2; ++part) {
            if (part == 0 && !tail) continue;
            if (part == 0 && bx < nsub) {
                const int sp = st - 1, lp = sp / 3, pp = sp % 3;
                if (pp != 1) { const int f = pp >> 1, a = f ? 6 : 0;
                    run_gemm(lds, wave_s, ACT, (const bf16_t*)(ws + OFF_WD + (size_t)(lp * 2 + f) * SZ_WD), NCTX, DM, FF, EpiResid{XL, XL, ws, lp, a + 2, f == 0 ? lp : 1, f == 0 ? 4 : (lp == 0 ? 1 : -1), 0.5f}, 0, NLAT / 256, nsub, bx);
                } else {
                    run_gemm(lds, wave_s, Y, (const bf16_t*)(ws + (lp == 0 ? OFF_WOUT0 : OFF_WOUT1)), NCTX, DM, DM, EpiResid{XL, XL, ws, lp, 5, lp, 7, 1.0f}, 0, NLAT / 256, nsub, bx);
                }
            }
            if (part == 1 || bx >= nsub) {
                const int pb = part == 0 ? 0 : P0, pe = part == 0 ? P0 : npan, Gs = part == 0 ? G - nsub : 0, cs = part == 0 ? bx - nsub : -1;
                if (pe > pb) {
                    if (ph != 1) { const int f = ph >> 1;
                        run_gemm(lds, wave_s, H, (const bf16_t*)(ws + OFF_WGU + (size_t)(l * 2 + f) * SZ_WGU), (pe - pb) * 256, 5632, DM, EpiSwiGLU{ACT, RS, BIAS + BIAS_FFN + (l * 2 + f) * 17 * 5632}, 0, pb, Gs, cs);
                    } else if (l == 0) {
                        run_gemm(lds, wave_s, H, (const bf16_t*)(ws + OFF_WQK0), (pe - pb) * 256, 1792, DM, EpiHeads0{(bf16_t*)(ws + OFF_QK0), (const float*)(ws + OFF_GAIN), rope64, RS, BIAS + BIAS_QK0}, 0, pb, Gs, cs);
                    } else {
                        run_gemm(lds, wave_s, H, (const bf16_t*)(ws + OFF_WIN1), (pe - pb) * 256, 2304, DM,
                                 EpiHeads1{(bf16_t*)(ws + OFF_QK1), (bf16_t*)(ws + OFF_CQ), (bf16_t*)(ws + OFF_CKV), (bf16_t*)(ws + OFF_KR), (float*)(ws + OFF_PQ), (float*)(ws + OFF_PKV), P->in[34], P->in[35], P->in[33], rope32, RS, BIAS + BIAS_IN1}, 0, pb, Gs, cs);
                    }
                }
            }
            if (part == 0) xcd_barrier(bar);
        }
        if (ph != 1) {
            const int f = ph >> 1, a = f ? 6 : 0; const bool last = (st == 5);
            xcd_barrier(bar);
            run_gemm(lds, wave_s, ACT, (const bf16_t*)(ws + OFF_WD + (size_t)(l * 2 + f) * SZ_WD), NLAT, DM, FF,
                     EpiResid{st == 0 ? P->in[0] : XL, XL, ws, l, a + 2, f == 0 ? l : 1, f == 0 ? 4 : (l == 0 ? 1 : -1), 0.5f});
            if (!last) xcd_barrier(bar);
        } else {
            run_gemm(lds, wave_s, (const bf16_t*)(ws + (l == 0 ? OFF_WV0 : OFF_WDV)), H, l == 0 ? 768 : 512, T, DM,
                     EpiPlain{(bf16_t*)(ws + (l == 0 ? OFF_VT0 : OFF_DVT)), T, nullptr, RS, BIAS + (l == 0 ? BIAS_V0 : BIAS_DV), l == 0 ? 768 : 512}, 128);
            xcd_barrier(bar);
            if (l == 1) {
                run_gemm(lds, wave_s, (const bf16_t*)(ws + OFF_CQ), (const bf16_t*)(ws + OFF_WUQ), NLAT, 768, 768, EpiUq{(bf16_t*)(ws + OFF_QC), (const float*)(ws + OFF_PQ), P->in[30], P->in[31], rope32});
                run_gemm(lds, wave_s, (const bf16_t*)(ws + OFF_CKV), (const bf16_t*)(ws + OFF_WUK), T, 512, 256, EpiUk{(bf16_t*)(ws + OFF_KC), (const float*)(ws + OFF_PKV), P->in[32]}, 128);
                run_gemm(lds, wave_s, (const bf16_t*)(ws + OFF_WUV), (const bf16_t*)(ws + OFF_CKV), 512, T, 256, EpiPlain{(bf16_t*)(ws + OFF_CVT), T, (const float*)(ws + OFF_PKV), nullptr, nullptr, 0}, 96);
                xcd_barrier(bar);
            }
            attn_phase(P, l, lds, wave_s);
            xcd_barrier(bar);
            run_gemm(lds, wave_s, Y, (const bf16_t*)(ws + (l == 0 ? OFF_WOUT0 : OFF_WOUT1)), NLAT, DM, DM, EpiResid{XL, XL, ws, l, 5, l, 7, 1.0f});
            xcd_barrier(bar);
        }
    }
}

extern "C" void kernel_launch(void* const* d_in, const int* in_sizes, int n_in, void* d_out, int out_size, void* d_ws, size_t ws_size, hipStream_t stream) {
    static int grid = 0;
    if (grid == 0) {
        if (n_in != 37 || ws_size < WS_END) { fprintf(stderr, "kernel_launch: unexpected n_in %d / ws %zu\n", n_in, ws_size); grid = -1; return; }
        int dev = 0, cus = 0, per_cu = 0;
        hipGetDevice(&dev); hipDeviceGetAttribute(&cus, hipDeviceAttributeMultiprocessorCount, dev);
        hipFuncSetAttribute((const void*)fwd_megakernel, hipFuncAttributeMaxDynamicSharedMemorySize, LDS_BYTES);
        hipOccupancyMaxActiveBlocksPerMultiprocessor(&per_cu, (const void*)fwd_megakernel, NWAVES * 64, LDS_BYTES);
        if (per_cu < 1) { fprintf(stderr, "kernel_launch: occupancy query says %d blocks per CU\n", per_cu); per_cu = 1; }
        (void)hipGetLastError();
        grid = cus;
    }
    if (grid < 0) return;
    if (hipMemsetAsync((char*)d_ws + OFF_CTL, 0, 16384, stream) != hipSuccess) { fprintf(stderr, "kernel_launch: memset failed\n"); return; }
    Params p{};
    for (int i = 0; i < 37; ++i) p.in[i] = (const float*)d_in[i];
    p.out = (float*)d_out; p.ws = (unsigned char*)d_ws;
    void* args[] = {&p};
    hipError_t e = hipLaunchCooperativeKernel((const void*)fwd_megakernel, dim3(grid), dim3(NWAVES * 64), args, LDS_BYTES, stream);
    if (e != hipSuccess) fprintf(stderr, "cooperative launch failed: %s (grid %d)\n", hipGetErrorString(e), grid);
}
```
